# Optimizing an MI355X kernel written in HIP

```python
import math
import jax, jax.numpy as jnp
from jax import lax
import numpy as np

D_MODEL = 1024
BATCH = 4
SEQ = 4096
DEPTH = 1

MLA_HEADS = 8
MLA_Q_RANK = 256
MLA_KV_RANK = 128
MLA_NOPE = 64
MLA_ROPE = 32
MLA_V = 64
SWA_Q_HEADS = 16
SWA_KV_HEADS = 2
SWA_HEAD = 64
WINDOW = 128
BLOCK = 128
REL_BUCKETS = 32
REL_MAX_DIST = 128
D_FF = 4 * D_MODEL
ROPE_THETA = 10000.0
EPS = 1e-6

IN_SIZES = (MLA_Q_RANK, MLA_KV_RANK, MLA_ROPE,
            SWA_Q_HEADS * SWA_HEAD, SWA_KV_HEADS * SWA_HEAD, SWA_KV_HEADS * SWA_HEAD,
            D_MODEL, D_MODEL)
D_IN = sum(IN_SIZES)

kernel_name = "hybrid_mla_swa_gated_adaln_block"


def rmsnorm(x, g):
    xf = x.astype(jnp.float32)
    y = xf * lax.rsqrt(jnp.mean(xf * xf, axis=-1, keepdims=True) + EPS)
    return (y * g.astype(jnp.float32)).astype(x.dtype)


def modulate(h, shift, scale):
    return h * (1 + scale[:, None, :]) + shift[:, None, :]


def apply_rope(t, pos):
    half = t.shape[-1] // 2
    inv = ROPE_THETA ** (-jnp.arange(half, dtype=jnp.float32) / half)
    ang = pos.astype(jnp.float32)[..., None] * inv
    cos = jnp.cos(ang)[:, :, None, :]
    sin = jnp.sin(ang)[:, :, None, :]
    t1 = t[..., :half].astype(jnp.float32)
    t2 = t[..., half:].astype(jnp.float32)
    return jnp.concatenate([t1 * cos - t2 * sin, t1 * sin + t2 * cos], axis=-1).astype(t.dtype)


def rel_bucket(rel):
    n = jnp.maximum(rel, 0)
    max_exact = REL_BUCKETS // 2
    nf = jnp.maximum(n, 1).astype(jnp.float32)
    large = max_exact + (jnp.log(nf / max_exact) / math.log(REL_MAX_DIST / max_exact)
                         * (REL_BUCKETS - max_exact)).astype(jnp.int32)
    large = jnp.minimum(large, REL_BUCKETS - 1)
    return jnp.where(n < max_exact, n, large)


def mla_attention(q_lat, kv_lat, k_rope_raw, pos, g_q, g_kv, w_uq, w_ukv):
    B, S, _ = q_lat.shape
    q = jnp.einsum('bsr,rhd->bshd', rmsnorm(q_lat, g_q), w_uq)
    q_nope = q[..., :MLA_NOPE]
    q_pe = apply_rope(q[..., MLA_NOPE:], pos)
    kv = jnp.einsum('bsr,rhd->bshd', rmsnorm(kv_lat, g_kv), w_ukv)
    k_nope = kv[..., :MLA_NOPE]
    v = kv[..., MLA_NOPE:]
    k_pe = apply_rope(k_rope_raw[:, :, None, :], pos)[:, :, 0, :]
    scale = (MLA_NOPE + MLA_ROPE) ** -0.5
    nblk = S // BLOCK
    qn = q_nope.reshape(B, nblk, BLOCK, MLA_HEADS, MLA_NOPE).transpose(1, 0, 2, 3, 4)
    qp = q_pe.reshape(B, nblk, BLOCK, MLA_HEADS, MLA_ROPE).transpose(1, 0, 2, 3, 4)
    k_idx = jnp.arange(S)

    def one_block(args):
        i, qn_i, qp_i = args
        s = (jnp.einsum('bqhd,bkhd->bhqk', qn_i, k_nope)
             + jnp.einsum('bqhd,bkd->bhqk', qp_i, k_pe)).astype(jnp.float32) * scale
        q_idx = i * BLOCK + jnp.arange(BLOCK)
        mask = k_idx[None, :] <= q_idx[:, None]
        s = jnp.where(mask[None, None], s, -jnp.inf)
        p = jax.nn.softmax(s, axis=-1).astype(v.dtype)
        return jnp.einsum('bhqk,bkhd->bqhd', p, v)

    out = lax.map(one_block, (jnp.arange(nblk), qn, qp))
    return out.transpose(1, 0, 2, 3, 4).reshape(B, S, MLA_HEADS * MLA_V)


def swa_attention(q, k, v, pos, sinks, rel_bias):
    B, S = q.shape[0], q.shape[1]
    nblk = S // BLOCK
    G = SWA_Q_HEADS // SWA_KV_HEADS
    qb = q.reshape(B, nblk, BLOCK, SWA_KV_HEADS, G, SWA_HEAD)

    def band(t):
        tb = t.reshape((B, nblk, BLOCK) + t.shape[2:])
        pad = [(0, 0), (1, 0)] + [(0, 0)] * (tb.ndim - 2)
        prev = jnp.pad(tb, pad)[:, :-1]
        return jnp.concatenate([prev, tb], axis=2)

    kb, vb = band(k), band(v)
    s = jnp.einsum('bnqhgd,bnkhd->bnhgqk', qb, kb).astype(jnp.float32) * (SWA_HEAD ** -0.5)
    pq = pos.reshape(B, nblk, BLOCK)
    pk = band(pos)
    bucket = rel_bucket(pq[..., :, None] - pk[..., None, :])
    bias = rel_bias[:, bucket]
    bias = bias.reshape((SWA_KV_HEADS, G) + bias.shape[1:]).transpose(2, 3, 0, 1, 4, 5)
    s = s + bias.astype(jnp.float32)
    a = jnp.arange(BLOCK)[:, None]
    b = jnp.arange(2 * BLOCK)[None, :]
    dist = BLOCK + a - b
    band_ok = (dist >= 0) & (dist < WINDOW)
    blk = jnp.arange(nblk)[:, None, None]
    k_ok = (blk * BLOCK - BLOCK + b[None]) >= 0
    mask = band_ok[None] & k_ok
    s = jnp.where(mask[None, :, None, None], s, -jnp.inf)
    sink = jnp.broadcast_to(
        sinks.reshape(SWA_KV_HEADS, G)[None, None, :, :, None, None].astype(jnp.float32),
        s.shape[:-1] + (1,))
    p = jax.nn.softmax(jnp.concatenate([s, sink], axis=-1), axis=-1)[..., :-1]
    out = jnp.einsum('bnhgqk,bnkhd->bnqhgd', p.astype(vb.dtype), vb)
    return out.reshape(B, S, SWA_Q_HEADS * SWA_HEAD)


def setup_inputs(seed: int = 0) -> dict:
    key = jax.random.key(seed)
    ks = jax.random.split(key, 24)
    f32 = jnp.float32
    nrm = lambda k, shape, s: jax.random.normal(k, shape, f32) * s
    x = jax.random.normal(ks[0], (BATCH, SEQ, D_MODEL), f32)
    c = jax.random.normal(ks[1], (BATCH, D_MODEL), f32)
    start = jax.random.randint(ks[2], (BATCH, 1), 0, 1024, dtype=jnp.int32)
    positions = start + jnp.arange(SEQ, dtype=jnp.int32)[None, :]
    return {
        "x": x,
        "c": c,
        "positions": positions,
        "rel_bias": nrm(ks[3], (SWA_Q_HEADS, REL_BUCKETS), 0.5),
        "ada_w": nrm(ks[4], (DEPTH, D_MODEL, 6 * D_MODEL), 0.5 * D_MODEL ** -0.5),
        "ada_b": nrm(ks[5], (DEPTH, 6 * D_MODEL), 0.02),
        "ln_mix_g": 1.0 + nrm(ks[6], (DEPTH, D_MODEL), 0.01),
        "w_in": nrm(ks[7], (DEPTH, D_MODEL, D_IN), D_MODEL ** -0.5),
        "b_gate": nrm(ks[8], (DEPTH, 2 * D_MODEL), 0.02),
        "mla_q_norm_g": 1.0 + nrm(ks[9], (DEPTH, MLA_Q_RANK), 0.01),
        "mla_kv_norm_g": 1.0 + nrm(ks[10], (DEPTH, MLA_KV_RANK), 0.01),
        "w_uq": nrm(ks[11], (DEPTH, MLA_Q_RANK, MLA_HEADS, MLA_NOPE + MLA_ROPE), MLA_Q_RANK ** -0.5),
        "w_ukv": nrm(ks[12], (DEPTH, MLA_KV_RANK, MLA_HEADS, MLA_NOPE + MLA_V), MLA_KV_RANK ** -0.5),
        "swa_sinks": nrm(ks[13], (DEPTH, SWA_Q_HEADS), 0.5),
        "w_o_mla": nrm(ks[14], (DEPTH, MLA_HEADS * MLA_V, D_MODEL), (MLA_HEADS * MLA_V) ** -0.5),
        "w_o_swa": nrm(ks[15], (DEPTH, SWA_Q_HEADS * SWA_HEAD, D_MODEL), (SWA_Q_HEADS * SWA_HEAD) ** -0.5),
        "w_o": nrm(ks[16], (DEPTH, D_MODEL, D_MODEL), D_MODEL ** -0.5),
        "ln_mlp_g": 1.0 + nrm(ks[17], (DEPTH, D_MODEL), 0.01),
        "w_ff1": nrm(ks[18], (DEPTH, D_MODEL, D_FF), D_MODEL ** -0.5),
        "w_ff2": nrm(ks[19], (DEPTH, D_FF, D_MODEL), D_FF ** -0.5),
        "ln_final_g": 1.0 + nrm(ks[20], (D_MODEL,), 0.01),
    }


def reference(x, c, positions, rel_bias, ada_w, ada_b, ln_mix_g, w_in, b_gate,
              mla_q_norm_g, mla_kv_norm_g, w_uq, w_ukv, swa_sinks, w_o_mla, w_o_swa, w_o,
              ln_mlp_g, w_ff1, w_ff2, ln_final_g):
    B, S, D = x.shape
    HQ, HKV = SWA_Q_HEADS, SWA_KV_HEADS
    bounds = []
    acc = 0
    for sz in IN_SIZES[:-1]:
        acc += sz
        bounds.append(acc)
    for l in range(DEPTH):
        mod = jax.nn.silu(c) @ ada_w[l] + ada_b[l]
        sh1, sc1, ga1, sh2, sc2, ga2 = jnp.split(mod, 6, axis=-1)

        h = modulate(rmsnorm(x, ln_mix_g[l]), sh1, sc1)
        proj = h @ w_in[l]
        q_lat, kv_lat, k_rope, q_s, k_s, v_s, gl_a, gl_b = jnp.split(proj, bounds, axis=-1)

        y_mla = mla_attention(q_lat, kv_lat, k_rope, positions,
                              mla_q_norm_g[l], mla_kv_norm_g[l], w_uq[l], w_ukv[l])
        y_swa = swa_attention(q_s.reshape(B, S, HQ, SWA_HEAD),
                              k_s.reshape(B, S, HKV, SWA_HEAD),
                              v_s.reshape(B, S, HKV, SWA_HEAD),
                              positions, swa_sinks[l], rel_bias)
        g_a = jax.nn.sigmoid(gl_a + b_gate[l, :D])
        g_b = jax.nn.sigmoid(gl_b + b_gate[l, D:])
        merged = g_a * (y_mla @ w_o_mla[l]) + g_b * (y_swa @ w_o_swa[l])
        x = x + ga1[:, None, :] * (merged @ w_o[l])

        h = modulate(rmsnorm(x, ln_mlp_g[l]), sh2, sc2)
        u = jnp.square(jax.nn.relu(h @ w_ff1[l]))
        x = x + ga2[:, None, :] * (u @ w_ff2[l])
    return rmsnorm(x, ln_final_g)
```

```cpp
#include <hip/hip_runtime.h>
#include <cstdio>
#include <cstdint>

#define GAS __attribute__((address_space(1)))
#define LAS __attribute__((address_space(3)))
typedef unsigned short bf16_t;
typedef short bf16x8 __attribute__((ext_vector_type(8)));
typedef short s16x4 __attribute__((ext_vector_type(4)));
typedef float f32x4 __attribute__((ext_vector_type(4)));
typedef float f32x16 __attribute__((ext_vector_type(16)));
typedef unsigned u32x4 __attribute__((ext_vector_type(4)));
typedef unsigned u32x2 __attribute__((ext_vector_type(2)));

constexpr int NB = 4, SEQ = 4096, DM = 1024, M = NB * SEQ, DFF = 4096;
constexpr int NIN = 3840;
constexpr float EPS = 1e-6f;
constexpr float LOG2E = 1.4426950408889634f;
constexpr float C2M = 0.10206207261596575f * LOG2E;
constexpr float C2S = 0.125f * LOG2E;

constexpr size_t MiB = 1u << 20;
constexpr size_t WS_CTL = 0, CTL_ZERO_BYTES = 1 * MiB;
constexpr size_t CTL_SSQ_Q = 256 * 1024, CTL_SSQ_KV = 320 * 1024, CTL_SSQ1 = 384 * 1024, CTL_SSQ2 = 448 * 1024;
constexpr size_t WS_WIN = 1 * MiB;
constexpr size_t WS_WUQ = WS_WIN + (size_t)NIN * 1024 * 2;
constexpr size_t WS_WUKV = WS_WUQ + 768 * 256 * 2;
constexpr size_t WS_WOMLA = WS_WUKV + 1024 * 128 * 2;
constexpr size_t WS_WOSWA = WS_WOMLA + 1024 * 512 * 2;
constexpr size_t WS_WO = WS_WOSWA + 1024 * 1024 * 2;
constexpr size_t WS_W1 = WS_WO + 1024 * 1024 * 2;
constexpr size_t WS_W2 = WS_W1 + (size_t)4096 * 1024 * 2;
constexpr size_t WS_MOD = WS_W2 + (size_t)4096 * 1024 * 2;
constexpr size_t WS_BIAS2 = WS_MOD + 4 * 6144 * 4;
constexpr size_t WS_TB = WS_BIAS2 + 4 * 4096 * 4;
constexpr size_t WS_SMALL_END = WS_TB + 16 * 132 * 4;
static_assert(WS_SMALL_END <= 32 * MiB, "small region");
constexpr size_t WS_QN = 32 * MiB, WS_QP = 48 * MiB, WS_KN = 56 * MiB, WS_VM = 72 * MiB, WS_CS = 88 * MiB, WS_SN = 89 * MiB;
constexpr size_t WS_X1B = 64 * MiB;
constexpr size_t WS_A2 = 32 * MiB;
constexpr size_t WS_QS = 96 * MiB, WS_GA = 128 * MiB, WS_GB = 160 * MiB, WS_QLAT = 192 * MiB, WS_KVLAT = 200 * MiB, WS_KPE = 204 * MiB, WS_KS = 205 * MiB, WS_VS = 209 * MiB;
constexpr size_t WS_U = 96 * MiB;
constexpr size_t WS_H = 224 * MiB, WS_MERGED = 224 * MiB;
constexpr size_t WS_END = 256 * MiB;
constexpr int CW_BAR = 4096, CW_FLAG = 64; constexpr unsigned CTL_READY = 0x5EED600Du;

constexpr int RING_BYTES = 131072, LDSCTL_OFF = RING_BYTES, MISC_OFF = LDSCTL_OFF + 320, LDS_BYTES = 147456;
constexpr int NWAVES = 8;

__device__ __forceinline__ unsigned f2bf(float f) { unsigned u = __builtin_bit_cast(unsigned, f); return (u + 0x7fffu + ((u >> 16) & 1u)) >> 16; }
__device__ __forceinline__ unsigned pk2(float lo, float hi) { return f2bf(lo) | (f2bf(hi) << 16); }
typedef float f32x2_t __attribute__((ext_vector_type(2))); typedef __bf16 bf16x2_t __attribute__((ext_vector_type(2)));
__device__ __forceinline__ unsigned cvt_pk_bf16(float lo, float hi) { f32x2_t v = {lo, hi}; bf16x2_t b = __builtin_convertvector(v, bf16x2_t); return __builtin_bit_cast(unsigned, b); }
__device__ __forceinline__ float bf2f(unsigned short b) { return __builtin_bit_cast(float, (unsigned)b << 16); }
__device__ __forceinline__ u32x2 pack4(f32x4 v) { u32x2 w; w.x = cvt_pk_bf16(v[0], v[1]); w.y = cvt_pk_bf16(v[2], v[3]); return w; }
__device__ __forceinline__ f32x4 unpack4(u32x2 w) { f32x4 v; v[0] = __builtin_bit_cast(float, w.x << 16); v[1] = __builtin_bit_cast(float, w.x & 0xffff0000u); v[2] = __builtin_bit_cast(float, w.y << 16); v[3] = __builtin_bit_cast(float, w.y & 0xffff0000u); return v; }

namespace pg8 {
constexpr int BM = 256, BK = 64, HALF = 128, HTB = HALF * BK * 2, STAGE_BYTES = 8 * HTB, NXCD = 8, WGM = 8;
__host__ __device__ __forceinline__ int lds_byte(int r, int c) { const int st = (r >> 4) * 2 + (c >> 5), rr = r & 15, cc = c & 31, ob = rr * 64 + cc * 2; return st * 1024 + (ob ^ (((ob >> 9) & 1) << 5)); }
__host__ __device__ __forceinline__ void stage_rc(int b, int& R, int& C) { const int st = b / 1024, sb = b % 1024, swz = sb ^ (((sb >> 9) & 1) << 5); R = (st >> 1) * 16 + swz / 64; C = (st & 1) * 32 + (swz % 64) / 2; }
__host__ __device__ __forceinline__ int perm32(int rho) { const int n = rho >> 4, i = rho & 15; return 8 * (i >> 2) + 4 * n + (i & 3); }
struct Unit { int pm, pn; };
__host__ __device__ __forceinline__ int pair_qb(int slot) { const int q = 4 * (slot >> 3) + ((slot & 7) >> 1); return (slot & 1) ? 15 - q : q; }
struct Gemm { const bf16_t* A; const bf16_t* Bt; int M, N, K; const bf16_t* A2; const bf16_t* Bt2; int K2; };
struct StaticOrder {
    int nM, nN, nwg, G, c; bool pp;
    __host__ __device__ void init(int M_, int N_, int G_, int c_, bool pp_ = false) { nM = M_ / BM; nN = N_ / BM; nwg = nM * nN; G = G_; c = c_; pp = pp_; }
    __host__ __device__ bool next(int i, Unit& u) const {
        const long L = (long)i * G + c; if (L >= nwg) return false;
        int wgid = (int)L; { const int q = nwg / NXCD, r = nwg % NXCD, xcd = wgid % NXCD, off = wgid / NXCD; wgid = (xcd < r ? xcd * (q + 1) : r * (q + 1) + (xcd - r) * q) + off; }
        const int nig = WGM * nN, gid = wgid / nig, fm = gid * WGM, gsz = (nM - fm) < WGM ? (nM - fm) : WGM;
        u.pm = fm + ((wgid % nig) % gsz); u.pn = (wgid % nig) / gsz;
        if (pp) u.pm = (u.pm & ~15) | pair_qb(u.pm & 15);
        return true;
    }
};
struct NoTail { template <class... A> __device__ __forceinline__ void operator()(A&&...) const {} };
template <class Epi, bool ALIGN_EPI, class Tail = NoTail, bool TWO = false, int TILED = 0>
__device__ __forceinline__ void gemm_phase(LAS unsigned char* lds, const Gemm g, const StaticOrder& S, const Epi& E, const Tail& T = Tail()) {
    int tid = threadIdx.x; asm volatile("" : "+v"(tid));
    const int wid = __builtin_amdgcn_readfirstlane(tid >> 6), lane = tid & 63, wr = wid >> 2, wc = wid & 3, fr = lane & 15, fq = lane >> 4;
    const int K = g.K, K2 = TWO ? g.K2 : 0, nt1 = K / BK, nt = nt1 + K2 / BK;
    unsigned voffA[2], voffB[2], voffA2[2], voffB2[2];
    constexpr bool TA = (TILED & 1) != 0, TB = (TILED & 2) != 0;
#pragma unroll
    for (int i = 0; i < 2; ++i) { int R, C; stage_rc(tid * 16 + i * 8192, R, C); const int Rb = (R & ~31) + perm32(R & 31);
        voffA[i] = (unsigned)(R * (TA ? BK : K) + C) * 2u; voffB[i] = (unsigned)(Rb * (TB ? BK : K) + C) * 2u;
        voffA2[i] = (unsigned)(R * (TA ? BK : K2) + C) * 2u; voffB2[i] = (unsigned)(Rb * (TB ? BK : K2) + C) * 2u; }
    const size_t kstepA = TA ? (size_t)BM * BK * 2 : (size_t)(BK * 2), kstepB = TB ? (size_t)BM * BK * 2 : (size_t)(BK * 2);
    const size_t hstepA = TA ? (size_t)HALF * BK * 2 : (size_t)HALF * K * 2, hstepA2 = TA ? (size_t)HALF * BK * 2 : (size_t)HALF * K2 * 2;
    const size_t hstepB = TB ? (size_t)HALF * BK * 2 : (size_t)HALF * K * 2, hstepB2 = TB ? (size_t)HALF * BK * 2 : (size_t)HALF * K2 * 2;
    const size_t tstepA = TA ? (size_t)nt1 * BM * BK * 2 : 2 * hstepA, tstepA2 = TA ? (size_t)(nt - nt1) * BM * BK * 2 : 2 * hstepA2;
    const size_t tstepB = TB ? (size_t)nt1 * BM * BK * 2 : 2 * hstepB, tstepB2 = TB ? (size_t)(nt - nt1) * BM * BK * 2 : 2 * hstepB2;
    const unsigned ldsw = (unsigned)wid * 1024u;
    const int aoff = lds_byte(wr * 64 + fr, fq * 8), boff = lds_byte(wc * 32 + fr, fq * 8);
#define PG8_SA(b, h) (((b) * 2 + (h)) * HTB)
#define PG8_SB(b, h) ((4 + (b) * 2 + (h)) * HTB)
#define PG8_STAGE(bufoff, gbase, voff) do { _Pragma("unroll") for (int _i = 0; _i < 2; ++_i) \
        __builtin_amdgcn_global_load_lds((const unsigned*)((const char*)(gbase) + (voff)[_i]), (LAS unsigned*)(lds + (bufoff) + ldsw + _i * 8192), 16, 0, 0); } while (0)
#define PG8_LDA(dst, b, h) do { _Pragma("unroll") for (int m = 0; m < 4; ++m) _Pragma("unroll") for (int k = 0; k < 2; ++k) dst[m][k] = *(const LAS bf16x8*)(lds + PG8_SA(b, h) + aoff + m * 2048 + k * 1024); } while (0)
#define PG8_LDB(dst, b, h) do { _Pragma("unroll") for (int n = 0; n < 2; ++n) _Pragma("unroll") for (int k = 0; k < 2; ++k) dst[n][k] = *(const LAS bf16x8*)(lds + PG8_SB(b, h) + boff + n * 2048 + k * 1024); } while (0)
#define PG8_MMA(ai, bj, At, Bt) do { __builtin_amdgcn_s_setprio(1); _Pragma("unroll") for (int m = 0; m < 4; ++m) _Pragma("unroll") for (int n = 0; n < 2; ++n) _Pragma("unroll") for (int k = 0; k < 2; ++k) \
        acc[ai][bj][m][n] = __builtin_amdgcn_mfma_f32_16x16x32_bf16(Bt[n][k], At[m][k], acc[ai][bj][m][n], 0, 0, 0); __builtin_amdgcn_s_setprio(0); } while (0)
#define PG8_WAIT_V(n) asm volatile("s_waitcnt vmcnt(" #n ")" ::: "memory")
#define PG8_WAIT_L(n) asm volatile("s_waitcnt lgkmcnt(" #n ")" ::: "memory")
#define PG8_BAR __builtin_amdgcn_s_barrier()
#define PG8_SCHED __builtin_amdgcn_sched_barrier(0)
    Unit cur, nxt; int ui = 0;
    if (!S.next(0, cur)) return;
    f32x4 acc[2][2][4][2];
#pragma unroll
    for (int a = 0; a < 2; ++a)
#pragma unroll
        for (int b = 0; b < 2; ++b)
#pragma unroll
            for (int m = 0; m < 4; ++m)
#pragma unroll
                for (int n = 0; n < 2; ++n) acc[a][b][m][n] = (f32x4){0.f, 0.f, 0.f, 0.f};
    bf16x8 At[4][2], B0[2][2], B1[2][2];
    const char* cA = (const char*)g.A + (size_t)cur.pm * tstepA; const char* cB = (const char*)g.Bt + (size_t)cur.pn * tstepB;
    const char* cA2 = TWO ? (const char*)g.A2 + (size_t)cur.pm * tstepA2 : nullptr; const char* cB2 = TWO ? (const char*)g.Bt2 + (size_t)cur.pn * tstepB2 : nullptr;
    PG8_STAGE(PG8_SB(0, 0), cB, voffB); PG8_STAGE(PG8_SB(0, 1), cB + hstepB, voffB); PG8_STAGE(PG8_SA(0, 0), cA, voffA); PG8_STAGE(PG8_SA(0, 1), cA + hstepA, voffA);
    if (wr == 1) PG8_BAR;
    PG8_WAIT_V(2); PG8_BAR;
    PG8_STAGE(PG8_SB(1, 0), cB + kstepB, voffB); PG8_STAGE(PG8_SA(1, 0), cA + kstepA, voffA); PG8_STAGE(PG8_SB(1, 1), cB + hstepB + kstepB, voffB);
    PG8_WAIT_V(6); PG8_BAR;
    for (;;) {
        const bool has_next = S.next(ui + 1, nxt);
        const char* nA = has_next ? (const char*)g.A + (size_t)nxt.pm * tstepA : cA; const char* nB = has_next ? (const char*)g.Bt + (size_t)nxt.pn * tstepB : cB;
        for (int t = 0; t < nt; t += 2) {
            const bool last = (t == nt - 2);
            if constexpr (TWO) { if (t == nt1) E.mid(acc, cur, wr, wc, fr, fq); }
            const bool s1 = !TWO || (t + 1 < nt1), s2 = !TWO || last || (t + 2 < nt1);
            const char* a1 = s1 ? cA + (size_t)(t + 1) * kstepA : cA2 + (size_t)(t + 1 - nt1) * kstepA; const size_t h1 = s1 ? hstepA : hstepA2; const unsigned vA1[2] = {s1 ? voffA[0] : voffA2[0], s1 ? voffA[1] : voffA2[1]};
            const char* a2 = last ? nA : (s2 ? cA + (size_t)(t + 2) * kstepA : cA2 + (size_t)(t + 2 - nt1) * kstepA);
            const char* b2 = last ? nB : (s2 ? cB + (size_t)(t + 2) * kstepB : cB2 + (size_t)(t + 2 - nt1) * kstepB);
            const size_t h2 = s2 ? hstepA : hstepA2, hb2 = s2 ? hstepB : hstepB2; const unsigned vA2[2] = {s2 ? voffA[0] : voffA2[0], s2 ? voffA[1] : voffA2[1]}, vB2[2] = {s2 ? voffB[0] : voffB2[0], s2 ? voffB[1] : voffB2[1]};
            const char* a3 = a2 + kstepA; const char* b3 = b2 + kstepB;
            PG8_LDB(B0, 0, 0); PG8_LDB(B1, 0, 1); PG8_SCHED; PG8_LDA(At, 0, 0); PG8_STAGE(PG8_SA(1, 1), a1 + h1, vA1);
            PG8_WAIT_V(8); PG8_WAIT_L(0); PG8_BAR; PG8_MMA(0, 0, At, B0); PG8_MMA(0, 1, At, B1); PG8_BAR; PG8_SCHED;
            PG8_LDA(At, 0, 1); PG8_STAGE(PG8_SB(0, 0), b2, vB2); PG8_STAGE(PG8_SB(0, 1), b2 + hb2, vB2); PG8_STAGE(PG8_SA(0, 0), a2, vA2);
            PG8_WAIT_V(8); PG8_WAIT_L(0); PG8_BAR; PG8_MMA(1, 0, At, B0); PG8_MMA(1, 1, At, B1); PG8_BAR; PG8_SCHED;
            PG8_LDB(B0, 1, 0); PG8_LDB(B1, 1, 1); PG8_SCHED; PG8_LDA(At, 1, 0); PG8_STAGE(PG8_SA(0, 1), a2 + h2, vA2);
            PG8_WAIT_V(8); PG8_WAIT_L(0); PG8_BAR; PG8_MMA(0, 0, At, B0); PG8_MMA(0, 1, At, B1); PG8_BAR; PG8_SCHED;
            PG8_LDA(At, 1, 1); PG8_STAGE(PG8_SB(1, 0), b3, vB2); PG8_STAGE(PG8_SB(1, 1), b3 + hb2, vB2); PG8_STAGE(PG8_SA(1, 0), a3, vA2);
            PG8_WAIT_V(8); PG8_WAIT_L(0); PG8_BAR; PG8_MMA(1, 0, At, B0); PG8_MMA(1, 1, At, B1); PG8_BAR; PG8_SCHED;
        }
        if constexpr (ALIGN_EPI) { if (wr == 0) PG8_BAR; }
        E(acc, cur, wr, wc, fr, fq);
        if (!has_next) break;
#pragma unroll
        for (int a = 0; a < 2; ++a)
#pragma unroll
            for (int b = 0; b < 2; ++b)
#pragma unroll
                for (int m = 0; m < 4; ++m)
#pragma unroll
                    for (int n = 0; n < 2; ++n) acc[a][b][m][n] = (f32x4){0.f, 0.f, 0.f, 0.f};
        cur = nxt; cA = nA; cB = nB; ++ui;
        if constexpr (TWO) { cA2 = (const char*)g.A2 + (size_t)cur.pm * tstepA2; cB2 = (const char*)g.Bt2 + (size_t)cur.pn * tstepB2; }
        if constexpr (ALIGN_EPI) { if (wr == 1) PG8_BAR; }
    }
    PG8_WAIT_V(0);
    if constexpr (!ALIGN_EPI) { if (wr == 0) PG8_BAR; }
    PG8_BAR;
    T(acc, cur, wr, wc, fr, fq);
#undef PG8_SA
#undef PG8_SB
#undef PG8_STAGE
#undef PG8_LDA
#undef PG8_LDB
#undef PG8_MMA
#undef PG8_WAIT_V
#undef PG8_WAIT_L
#undef PG8_BAR
#undef PG8_SCHED
}
}

#define EPI_ARGS f32x4 (&acc)[2][2][4][2], const pg8::Unit& u, int wr, int wc, int fr, int fq
#define FOR_AI_M _Pragma("unroll") for (int ai = 0; ai < 2; ++ai) _Pragma("unroll") for (int m = 0; m < 4; ++m)
#define FOR_BJ_N _Pragma("unroll") for (int bj = 0; bj < 2; ++bj) _Pragma("unroll") for (int n = 0; n < 2; ++n)
__device__ __forceinline__ float quad_sum(float s) { s += __shfl_xor(s, 16); s += __shfl_xor(s, 32); return s; }
__device__ __forceinline__ float ld_agent(const float* p) { return __hip_atomic_load(p, __ATOMIC_RELAXED, __HIP_MEMORY_SCOPE_AGENT); }
__device__ __forceinline__ float sigmoidf(float v) { return __builtin_amdgcn_rcpf(1.f + __expf(-v)); }

__device__ __forceinline__ u32x4 pack8(f32x4 a, f32x4 b) { u32x4 w; w.x = cvt_pk_bf16(a[0], a[1]); w.y = cvt_pk_bf16(a[2], a[3]); w.z = cvt_pk_bf16(b[0], b[1]); w.w = cvt_pk_bf16(b[2], b[3]); return w; }
__device__ __forceinline__ void unpack8(u32x4 w, f32x4& a, f32x4& b) { a = unpack4((u32x2){w.x, w.y}); b = unpack4((u32x2){w.z, w.w}); }
__device__ __forceinline__ float sumsq8(f32x4 a, f32x4 b) { return ((a[0] * a[0] + a[1] * a[1]) + (a[2] * a[2] + a[3] * a[3])) + ((b[0] * b[0] + b[1] * b[1]) + (b[2] * b[2] + b[3] * b[3])); }
#define FOR_BJ _Pragma("unroll") for (int bj = 0; bj < 2; ++bj)

struct EpiP1 {
    bf16_t *QLAT, *KVLAT, *KPE, *QS, *KS, *VS, *GA, *GB; float *ssq_q, *ssq_kv; const float *cs, *sn, *bgate;
    __device__ __forceinline__ void operator()(EPI_ARGS) const {
        const int pn = u.pn, row0 = u.pm * 256 + wr * 64 + fr, cl = wc * 32 + fq * 8;
        if (pn == 0) {
            FOR_AI_M { const int row = row0 + ai * 128 + m * 16; float s = 0.f;
                FOR_BJ { s += sumsq8(acc[ai][bj][m][0], acc[ai][bj][m][1]); *(u32x4*)(QLAT + (size_t)row * 256 + bj * 128 + cl) = pack8(acc[ai][bj][m][0], acc[ai][bj][m][1]); }
                s = quad_sum(s); if (fq == 0) unsafeAtomicAdd(ssq_q + row, s); }
        } else if (pn == 1) {
            FOR_AI_M { const int row = row0 + ai * 128 + m * 16;
                float s = sumsq8(acc[ai][0][m][0], acc[ai][0][m][1]); *(u32x4*)(KVLAT + (size_t)row * 128 + cl) = pack8(acc[ai][0][m][0], acc[ai][0][m][1]);
                s = quad_sum(s); if (fq == 0) unsafeAtomicAdd(ssq_kv + row, s);
                if (wc == 0) { const f32x4 t1 = acc[ai][1][m][0], t2 = acc[ai][1][m][1]; const f32x4 c = *(const f32x4*)(cs + (size_t)row * 16 + fq * 4), sv = *(const f32x4*)(sn + (size_t)row * 16 + fq * 4);
                    *(u32x4*)(KPE + (size_t)row * 32 + fq * 8) = pack8(t1 * c - t2 * sv, t1 * sv + t2 * c); } }
        } else if (pn < 6) {
            const int cb = (pn - 2) * 256;
            FOR_AI_M { const int row = row0 + ai * 128 + m * 16;
                FOR_BJ *(u32x4*)(QS + (size_t)row * 1024 + cb + bj * 128 + cl) = pack8(acc[ai][bj][m][0] * C2S, acc[ai][bj][m][1] * C2S); }
        } else if (pn == 6) {
            FOR_AI_M { const int row = row0 + ai * 128 + m * 16;
                *(u32x4*)(KS + (size_t)row * 128 + cl) = pack8(acc[ai][0][m][0], acc[ai][0][m][1]); *(u32x4*)(VS + (size_t)row * 128 + cl) = pack8(acc[ai][1][m][0], acc[ai][1][m][1]); }
        } else {
            const int cb = (pn - 7) * 128 + cl; const float* bg = bgate + cb;
            f32x4 ba[2], bb[2];
#pragma unroll
            for (int n = 0; n < 2; ++n) { ba[n] = *(const f32x4*)(bg + n * 4); bb[n] = *(const f32x4*)(bg + 1024 + n * 4); }
            FOR_AI_M { const int row = row0 + ai * 128 + m * 16; f32x4 r[2], gb[2];
#pragma unroll
                for (int n = 0; n < 2; ++n) { const f32x4 va = acc[ai][0][m][n] + ba[n], vb = acc[ai][1][m][n] + bb[n];
#pragma unroll
                    for (int j = 0; j < 4; ++j) { const float eb1 = 1.f + fminf(__expf(-vb[j]), 1e30f); gb[n][j] = __builtin_amdgcn_rcpf(eb1); r[n][j] = eb1 * sigmoidf(va[j]); } }
                *(u32x4*)(GA + (size_t)row * 1024 + cb) = pack8(r[0], r[1]); *(u32x4*)(GB + (size_t)row * 1024 + cb) = pack8(gb[0], gb[1]); }
        }
    }
};
struct EpiQ {
    bf16_t *QN, *QP; const float *ssq_q, *cs, *sn;
    __device__ __forceinline__ void operator()(EPI_ARGS) const {
        const int pn = u.pn, row0 = u.pm * 256 + wr * 64 + fr, cl = wc * 32 + fq * 8;
        if (pn < 2) {
            FOR_AI_M { const int row = row0 + ai * 128 + m * 16; const float rs = __builtin_amdgcn_rsqf(ld_agent(ssq_q + row) * (1.f / 256.f) + EPS) * C2M;
                FOR_BJ *(u32x4*)(QN + (size_t)row * 512 + pn * 256 + bj * 128 + cl) = pack8(acc[ai][bj][m][0] * rs, acc[ai][bj][m][1] * rs); }
        } else {
            FOR_AI_M { const int row = row0 + ai * 128 + m * 16; const float rs = __builtin_amdgcn_rsqf(ld_agent(ssq_q + row) * (1.f / 256.f) + EPS) * C2M;
                const f32x4 c = *(const f32x4*)(cs + (size_t)row * 16 + fq * 4) * rs, sv = *(const f32x4*)(sn + (size_t)row * 16 + fq * 4) * rs;
                FOR_BJ { const f32x4 t1 = acc[ai][bj][m][0], t2 = acc[ai][bj][m][1];
                    *(u32x4*)(QP + (size_t)row * 256 + (bj * 4 + wc) * 32 + fq * 8) = pack8(t1 * c - t2 * sv, t1 * sv + t2 * c); }
                asm volatile("" ::: "memory"); }
        }
    }
};
struct EpiKV {
    bf16_t *KN, *VM; const float* ssq_kv;
    __device__ __forceinline__ void operator()(EPI_ARGS) const {
        const int pn = u.pn, row0 = u.pm * 256 + wr * 64 + fr, cl = wc * 32 + fq * 8; bf16_t* O = (pn < 2 ? KN : VM) + (pn & 1) * 256;
        FOR_AI_M { const int row = row0 + ai * 128 + m * 16; const float rs = __builtin_amdgcn_rsqf(ld_agent(ssq_kv + row) * (1.f / 128.f) + EPS);
            FOR_BJ *(u32x4*)(O + (size_t)row * 512 + bj * 128 + cl) = pack8(acc[ai][bj][m][0] * rs, acc[ai][bj][m][1] * rs); }
    }
};
struct EpiMerge {
    const bf16_t *GA, *GB; bf16_t* T;
    __device__ __forceinline__ void mid(EPI_ARGS) const {
        int row0 = u.pm * 256 + wr * 64 + fr; const int c0 = u.pn * 256 + wc * 32 + fq * 8;
        asm volatile("" : "+v"(row0));
        FOR_AI_M { const int row = row0 + ai * 128 + m * 16;
            FOR_BJ { const size_t off = (size_t)row * 1024 + c0 + bj * 128; f32x4 r0, r1; unpack8(*(const u32x4*)(GA + off), r0, r1);
                acc[ai][bj][m][0] *= r0; acc[ai][bj][m][1] *= r1; }
            if (m & 1) asm volatile("" ::: "memory"); }
    }
    __device__ __forceinline__ void operator()(EPI_ARGS) const {
        const int row0 = u.pm * 256 + wr * 64 + fr, c0 = u.pn * 256 + wc * 32 + fq * 8;
        FOR_AI_M { const int row = row0 + ai * 128 + m * 16;
            FOR_BJ { const size_t off = (size_t)row * 1024 + c0 + bj * 128; f32x4 g0, g1; unpack8(*(const u32x4*)(GB + off), g0, g1);
                *(u32x4*)(T + off) = pack8(g0 * acc[ai][bj][m][0], g1 * acc[ai][bj][m][1]); } }
    }
};
struct EpiX1 {
    const float* x; bf16_t* X1B; bf16_t* A2; float* ssq1; const float* mod; const float* gmlp;
    __device__ __forceinline__ void operator()(EPI_ARGS) const {
        const int row0 = u.pm * 256 + wr * 64 + fr, c0 = u.pn * 256 + wc * 32 + fq * 8; const float* mb = mod + (size_t)(u.pm >> 4) * 6144;
        f32x4 ga[2][2], gm[2][2];
        FOR_BJ_N { const int c = c0 + bj * 128 + n * 4; ga[bj][n] = *(const f32x4*)(mb + 2 * 1024 + c); gm[bj][n] = (*(const f32x4*)(mb + 4 * 1024 + c) + 1.f) * *(const f32x4*)(gmlp + c); }
        FOR_AI_M { const int row = row0 + ai * 128 + m * 16; float s = 0.f;
            FOR_BJ { const size_t off = (size_t)row * 1024 + c0 + bj * 128;
                const f32x4 v0 = __builtin_nontemporal_load((const f32x4*)(x + off)) + ga[bj][0] * acc[ai][bj][m][0], v1 = __builtin_nontemporal_load((const f32x4*)(x + off + 4)) + ga[bj][1] * acc[ai][bj][m][1];
                s += sumsq8(v0, v1); *(u32x4*)(X1B + off) = pack8(v0, v1); *(u32x4*)(A2 + ((size_t)(u.pm * 16 + u.pn * 4 + bj * 2 + (wc >> 1)) * 256 + (row & 255)) * 64 + (wc & 1) * 32 + fq * 8) = pack8(v0 * gm[bj][0], v1 * gm[bj][1]); }
            s = quad_sum(s); if (fq == 0) unsafeAtomicAdd(ssq1 + row, s); }
    }
};
struct EpiFF1 {
    bf16_t* U; const float* ssq1; const float* bias2;
    __device__ __forceinline__ void operator()(EPI_ARGS) const {
        const int row0 = u.pm * 256 + wr * 64 + fr, c0 = u.pn * 256 + wc * 32 + fq * 8; const float* bb = bias2 + (size_t)(u.pm >> 4) * 4096;
        f32x4 bv[2][2];
        FOR_BJ_N bv[bj][n] = *(const f32x4*)(bb + c0 + bj * 128 + n * 4);
        FOR_AI_M { const int row = row0 + ai * 128 + m * 16; const float rs = __builtin_amdgcn_rsqf(ld_agent(ssq1 + row) * (1.f / 1024.f) + EPS);
            FOR_BJ { f32x4 v0 = acc[ai][bj][m][0] * rs + bv[bj][0], v1 = acc[ai][bj][m][1] * rs + bv[bj][1];
                v0[0] = fmaxf(v0[0], 0.f); v0[1] = fmaxf(v0[1], 0.f); v0[2] = fmaxf(v0[2], 0.f); v0[3] = fmaxf(v0[3], 0.f); v1[0] = fmaxf(v1[0], 0.f); v1[1] = fmaxf(v1[1], 0.f); v1[2] = fmaxf(v1[2], 0.f); v1[3] = fmaxf(v1[3], 0.f);
                *(u32x4*)(U + ((size_t)(u.pm * 64 + u.pn * 4 + bj * 2 + (wc >> 1)) * 256 + (row & 255)) * 64 + (wc & 1) * 32 + fq * 8) = pack8(v0 * v0, v1 * v1); } }
    }
};
struct EpiX2 {
    const bf16_t* X1B; float* X; float* ssq2; const float* mod; bool fuse;
    __device__ __forceinline__ void operator()(EPI_ARGS) const {
        const int row0 = u.pm * 256 + wr * 64 + fr, c0 = u.pn * 256 + wc * 32 + fq * 8; const float* mb = mod + (size_t)(u.pm >> 4) * 6144;
        f32x4 ga[2][2];
        FOR_BJ_N ga[bj][n] = *(const f32x4*)(mb + 5 * 1024 + c0 + bj * 128 + n * 4);
        FOR_AI_M { const int row = row0 + ai * 128 + m * 16; float s = 0.f;
            FOR_BJ { const size_t off = (size_t)row * 1024 + c0 + bj * 128; f32x4 x0, x1v; unpack8(*(const u32x4*)(X1B + off), x0, x1v);
                const f32x4 v0 = x0 + ga[bj][0] * acc[ai][bj][m][0], v1 = x1v + ga[bj][1] * acc[ai][bj][m][1];
                s += sumsq8(v0, v1); if (fuse) { acc[ai][bj][m][0] = v0; acc[ai][bj][m][1] = v1; } else { *(f32x4*)(X + off) = v0; *(f32x4*)(X + off + 4) = v1; } }
            s = quad_sum(s); if (fq == 0) unsafeAtomicAdd(ssq2 + row, s); }
    }
};
namespace att {
constexpr int VB = 8192;
constexpr float THR = 8.f;
__device__ __forceinline__ void glds16(const void* g, LAS unsigned char* l) { unsigned keep; const unsigned dst = (unsigned)__builtin_amdgcn_readfirstlane((int)(unsigned)(uintptr_t)l);
    asm volatile("s_mov_b32 %0, m0\n\ts_mov_b32 m0, %2\n\ts_nop 0\n\tglobal_load_lds_dwordx4 %1, off\n\ts_mov_b32 m0, %0" : "=&s"(keep) : "v"(g), "s"(dst) : "memory"); }
__device__ __forceinline__ s16x4 vtr(const LAS unsigned char* p) { return __builtin_bit_cast(s16x4, __builtin_amdgcn_ds_read_tr16_b64_v4i16((LAS s16x4*)p)); }
__device__ __forceinline__ float max3(float a, float b, float c) { return fmaxf(fmaxf(a, b), c); }
#define ATT_WAITBAR_N(n) do { if ((n) == 0) ATT_WAITBAR(0); else if ((n) == 1) ATT_WAITBAR(1); else if ((n) == 2) ATT_WAITBAR(2); else ATT_WAITBAR(3); } while (0)
#define ATT_WAITBAR(N) do { asm volatile("s_waitcnt vmcnt(" #N ") lgkmcnt(0)" ::: "memory"); __builtin_amdgcn_s_barrier(); asm volatile("" ::: "memory"); } while (0)
struct State { float m; f32x16 negm, lacc, o[2]; };
#define SBAR() __builtin_amdgcn_sched_barrier(0)
#define K_RD(i) asm volatile("ds_read_b128 %0, %1 offset:%c2" : "=v"(kf[i]) : "v"(kaddr), "i"(((i) >> 1) * 2048 + ((i) & 1) * 512) : "memory")
#define V_RD(i) asm volatile("ds_read_b64_tr_b16 %0, %1 offset:%c2" : "=v"(vf[i]) : "v"(vaddr), "i"(((((i) >> 1) & 3) * 1024) + (((i) & 1) * 512)) : "memory")
template <int NKS> __device__ __forceinline__ void k_issue(bf16x8* kf, unsigned kaddr) {
    K_RD(0); K_RD(1); K_RD(2); K_RD(3); K_RD(4); K_RD(5); K_RD(6); K_RD(7);
    if constexpr (NKS == 6) { K_RD(8); K_RD(9); K_RD(10); K_RD(11); }
}
template <int NKS> __device__ __forceinline__ void k_fence(bf16x8* kf) {
    if constexpr (NKS == 6) asm volatile("" : "+v"(kf[0]), "+v"(kf[1]), "+v"(kf[2]), "+v"(kf[3]), "+v"(kf[4]), "+v"(kf[5]), "+v"(kf[6]), "+v"(kf[7]), "+v"(kf[8]), "+v"(kf[9]), "+v"(kf[10]), "+v"(kf[11]));
    else asm volatile("" : "+v"(kf[0]), "+v"(kf[1]), "+v"(kf[2]), "+v"(kf[3]), "+v"(kf[4]), "+v"(kf[5]), "+v"(kf[6]), "+v"(kf[7]));
}
__device__ __forceinline__ void v_issue(s16x4* vf, unsigned vaddr) {
    V_RD(0); V_RD(1); V_RD(2); V_RD(3); V_RD(4); V_RD(5); V_RD(6); V_RD(7);
}
__device__ __forceinline__ void v_wait(s16x4* vf) {
    asm volatile("s_waitcnt lgkmcnt(0)" : "+v"(vf[0]), "+v"(vf[1]), "+v"(vf[2]), "+v"(vf[3]), "+v"(vf[4]), "+v"(vf[5]), "+v"(vf[6]), "+v"(vf[7]));
}
__device__ __forceinline__ void v_wait8(s16x4* vf) {
    asm volatile("s_waitcnt lgkmcnt(8)" : "+v"(vf[0]), "+v"(vf[1]), "+v"(vf[2]), "+v"(vf[3]), "+v"(vf[4]), "+v"(vf[5]), "+v"(vf[6]), "+v"(vf[7]));
}
__device__ __forceinline__ void k_wait8_4(bf16x8* kf) {
    asm volatile("s_waitcnt lgkmcnt(8)" : "+v"(kf[0]), "+v"(kf[1]), "+v"(kf[2]), "+v"(kf[3]), "+v"(kf[4]), "+v"(kf[5]), "+v"(kf[6]), "+v"(kf[7]));
}
template <int NKS> __device__ __forceinline__ void k_wait(bf16x8* kf) {
    if constexpr (NKS == 6) asm volatile("s_waitcnt lgkmcnt(0)" : "+v"(kf[0]), "+v"(kf[1]), "+v"(kf[2]), "+v"(kf[3]), "+v"(kf[4]), "+v"(kf[5]), "+v"(kf[6]), "+v"(kf[7]), "+v"(kf[8]), "+v"(kf[9]), "+v"(kf[10]), "+v"(kf[11]));
    else asm volatile("s_waitcnt lgkmcnt(0)" : "+v"(kf[0]), "+v"(kf[1]), "+v"(kf[2]), "+v"(kf[3]), "+v"(kf[4]), "+v"(kf[5]), "+v"(kf[6]), "+v"(kf[7]));
}
template <int NKS> __device__ __forceinline__ void qk_mma(f32x16& p0, f32x16& p1, const bf16x8* kf, const bf16x8* qr, const f32x16& negm) {
#pragma unroll
    for (int ks = 0; ks < NKS; ++ks) {
        if (ks == 0) { p0 = __builtin_amdgcn_mfma_f32_32x32x16_bf16(kf[0], qr[0], negm, 0, 0, 0); p1 = __builtin_amdgcn_mfma_f32_32x32x16_bf16(kf[1], qr[0], negm, 0, 0, 0); }
        else { p0 = __builtin_amdgcn_mfma_f32_32x32x16_bf16(kf[2 * ks], qr[ks], p0, 0, 0, 0); p1 = __builtin_amdgcn_mfma_f32_32x32x16_bf16(kf[2 * ks + 1], qr[ks], p1, 0, 0, 0); }
    }
}
__device__ __forceinline__ void decide(f32x16& c0, f32x16& c1, bool first, State& st) {
    float a = max3(c0[0], c0[1], c1[0]), b = max3(c0[2], c0[3], c1[1]); a = max3(a, c1[2], c1[3]);
#pragma unroll
    for (int r = 4; r < 16; r += 4) { a = max3(a, c0[r], c0[r + 1]); b = max3(b, c0[r + 2], c0[r + 3]); a = max3(a, c1[r], c1[r + 1]); b = max3(b, c1[r + 2], c1[r + 3]); }
    float mx = fmaxf(a, b);
    { auto rr = __builtin_amdgcn_permlane32_swap(__float_as_uint(mx), __float_as_uint(mx), false, false); mx = fmaxf(__uint_as_float(rr[0]), __uint_as_float(rr[1])); }
    if (first || __any(mx > THR)) {
        const float dl = first ? mx : fmaxf(mx, 0.f), f = __builtin_amdgcn_exp2f(-dl);
        st.m += dl;
#pragma unroll
        for (int r = 0; r < 16; ++r) { c0[r] -= dl; c1[r] -= dl; st.negm[r] = -st.m; st.o[0][r] *= f; st.o[1][r] *= f; st.lacc[r] *= f; }
    }
}
__device__ __forceinline__ void exp_pack(f32x16& p0, f32x16& p1, bf16x8* pa) {
#pragma unroll
    for (int r = 0; r < 16; ++r) { p0[r] = __builtin_amdgcn_exp2f(p0[r]); p1[r] = __builtin_amdgcn_exp2f(p1[r]); }
    u32x4 w0 = {cvt_pk_bf16(p0[0], p0[1]), cvt_pk_bf16(p0[2], p0[3]), cvt_pk_bf16(p0[4], p0[5]), cvt_pk_bf16(p0[6], p0[7])};
    u32x4 w1 = {cvt_pk_bf16(p0[8], p0[9]), cvt_pk_bf16(p0[10], p0[11]), cvt_pk_bf16(p0[12], p0[13]), cvt_pk_bf16(p0[14], p0[15])};
    u32x4 w2 = {cvt_pk_bf16(p1[0], p1[1]), cvt_pk_bf16(p1[2], p1[3]), cvt_pk_bf16(p1[4], p1[5]), cvt_pk_bf16(p1[6], p1[7])};
    u32x4 w3 = {cvt_pk_bf16(p1[8], p1[9]), cvt_pk_bf16(p1[10], p1[11]), cvt_pk_bf16(p1[12], p1[13]), cvt_pk_bf16(p1[14], p1[15])};
    pa[0] = __builtin_bit_cast(bf16x8, w0); pa[1] = __builtin_bit_cast(bf16x8, w1); pa[2] = __builtin_bit_cast(bf16x8, w2); pa[3] = __builtin_bit_cast(bf16x8, w3);
}
template <bool LSUM> __device__ __forceinline__ void pv_mma(f32x16& o, f32x16& lacc, const s16x4* vf, const bf16x8* pa) {
    const u32x4 onew = {0x3f803f80u, 0x3f803f80u, 0x3f803f80u, 0x3f803f80u}; const bf16x8 ones = __builtin_bit_cast(bf16x8, onew);
#pragma unroll
    for (int ks = 0; ks < 4; ++ks) {
        if (LSUM) lacc = __builtin_amdgcn_mfma_f32_32x32x16_bf16(ones, pa[ks], lacc, 0, 0, 0);
        const s16x4 lo = vf[ks * 2], hh = vf[ks * 2 + 1];
        const bf16x8 v = {lo[0], lo[1], lo[2], lo[3], hh[0], hh[1], hh[2], hh[3]};
        o = __builtin_amdgcn_mfma_f32_32x32x16_bf16(v, pa[ks], o, 0, 0, 0);
    }
}
__device__ __forceinline__ void store_o(bf16_t* orow, const f32x16* o, float inv, int hi) {
#pragma unroll
    for (int d0 = 0; d0 < 2; ++d0)
#pragma unroll
        for (int g = 0; g < 4; ++g) { f32x4 v = {o[d0][4 * g], o[d0][4 * g + 1], o[d0][4 * g + 2], o[d0][4 * g + 3]}; *(u32x2*)(orow + d0 * 32 + 8 * g + 4 * hi) = pack4(v * inv); }
}

constexpr int MLA_KB = 12288, MLA_NK = 4, MLA_NV = 4, MLA_V0 = MLA_NK * MLA_KB, MLA_LDS = MLA_V0 + MLA_NV * VB;
__device__ __forceinline__ void mla_mask(f32x16& p0, f32x16& p1, int t, int qrow, int hi) {
    const int kb = 64 * t + 4 * hi;
#pragma unroll
    for (int r = 0; r < 16; ++r) { const int kv = kb + (r & 3) + 8 * (r >> 2); if (kv > qrow) p0[r] = -INFINITY; if (kv + 32 > qrow) p1[r] = -INFINITY; }
}
struct St2 { float m, l; f32x16 o[2], negm; };
__device__ __forceinline__ bf16x8 ldv2(const LAS unsigned char* p) { const s16x4 lo = vtr(p), hh = vtr(p + 512); return (bf16x8){lo[0], lo[1], lo[2], lo[3], hh[0], hh[1], hh[2], hh[3]}; }
template <bool DO_PV, bool DO_QK>
__device__ __forceinline__ float mla_iter(f32x16& s0, f32x16& s1, f32x16& n0, f32x16& n1, const bf16x8* pin, bf16x8* pout, St2& st, const bf16x8* qr,
                                          const LAS unsigned char* kslot, const LAS unsigned char* vslot, bool MASK, bool first, bool grpB, int nis, int t, int qrow, int r32, int hi, int lane) {
    const LAS unsigned char* vp = vslot + ((lane >> 4) & 1) * 32 + (lane & 3) * 8 + (4 * hi + ((lane & 15) >> 2)) * 64;
    const LAS unsigned char* kb = kslot + hi * 1024 + r32 * 16;
    if (MASK) mla_mask(s0, s1, t, qrow, hi);
#define LDV(ks, d0) (DO_PV ? ldv2(vp + (d0) * 4096 + (ks) * 1024) : (bf16x8){0, 0, 0, 0, 0, 0, 0, 0})
#define LDK(ks, hf) (DO_QK ? *(const LAS bf16x8*)(kb + (ks) * 2048 + (hf) * 512) : (bf16x8){0, 0, 0, 0, 0, 0, 0, 0})
    const bf16x8 fr0 = LDV(0, 0);
    const bf16x8 fr1 = LDV(0, 1);
    const bf16x8 fr2 = LDV(1, 0);
    const bf16x8 fr3 = LDV(1, 1);
    if (DO_PV) st.o[0] = __builtin_amdgcn_mfma_f32_32x32x16_bf16(fr0, pin[0], st.o[0], 0, 0, 0);
    float a = max3(s0[0], s0[1], s1[0]), b = max3(s0[2], s0[3], s1[1]);
    a = max3(a, s1[2], s1[3]);
    a = max3(a, s0[4], s0[5]); b = max3(b, s0[6], s0[7]);
    a = max3(a, s1[4], s1[5]); b = max3(b, s1[6], s1[7]);
    asm volatile("" : "+v"(a), "+v"(b));
    SBAR();
    const bf16x8 fr4 = LDV(2, 0);
    if (DO_PV) st.o[1] = __builtin_amdgcn_mfma_f32_32x32x16_bf16(fr1, pin[0], st.o[1], 0, 0, 0);
    a = max3(a, s0[8], s0[9]); b = max3(b, s0[10], s0[11]);
    a = max3(a, s1[8], s1[9]); b = max3(b, s1[10], s1[11]);
    a = max3(a, s0[12], s0[13]); b = max3(b, s0[14], s0[15]);
    a = max3(a, s1[12], s1[13]); b = max3(b, s1[14], s1[15]);
    asm volatile("" : "+v"(a), "+v"(b));
    SBAR();
    const bf16x8 fr5 = LDV(2, 1);
    if (DO_PV) st.o[0] = __builtin_amdgcn_mfma_f32_32x32x16_bf16(fr2, pin[1], st.o[0], 0, 0, 0);
    float mx = fmaxf(a, b);
    { auto rr = __builtin_amdgcn_permlane32_swap(__float_as_uint(mx), __float_as_uint(mx), false, false); mx = fmaxf(__uint_as_float(rr[0]), __uint_as_float(rr[1])); }
    asm volatile("" : "+v"(mx));
    SBAR();
    const bf16x8 fr6 = LDV(3, 0);
    if (DO_PV) st.o[1] = __builtin_amdgcn_mfma_f32_32x32x16_bf16(fr3, pin[1], st.o[1], 0, 0, 0);
    float f = 1.f;
    if (first || __any(mx > THR)) {
        const float dl = (first || mx > THR) ? mx : 0.f; f = __builtin_amdgcn_exp2f(-dl); st.m += dl;
        _Pragma("unroll") for (int r = 0; r < 16; ++r) { s0[r] -= dl; s1[r] -= dl; st.negm[r] = -st.m; }
    }
    float sum = 0.f;
    u32x4 w0 = {0u, 0u, 0u, 0u}, w1 = w0, w2 = w0, w3 = w0;
    SBAR();
    const bf16x8 fr7 = LDV(3, 1);
    if (DO_PV) st.o[0] = __builtin_amdgcn_mfma_f32_32x32x16_bf16(fr4, pin[2], st.o[0], 0, 0, 0);
    s0[0] = __builtin_amdgcn_exp2f(s0[0]); sum += s0[0];
    s0[1] = __builtin_amdgcn_exp2f(s0[1]); sum += s0[1];
    asm volatile("" : "+v"(sum));
    SBAR();
    const bf16x8 fr8 = LDK(0, 0);
    if (DO_PV) st.o[1] = __builtin_amdgcn_mfma_f32_32x32x16_bf16(fr5, pin[2], st.o[1], 0, 0, 0);
    s0[2] = __builtin_amdgcn_exp2f(s0[2]); sum += s0[2];
    s0[3] = __builtin_amdgcn_exp2f(s0[3]); sum += s0[3];
    w0[0] = cvt_pk_bf16(s0[0], s0[1]);
    asm volatile("" : "+v"(sum), "+v"(w0));
    SBAR();
    const bf16x8 fr9 = LDK(0, 1);
    if (DO_PV) st.o[0] = __builtin_amdgcn_mfma_f32_32x32x16_bf16(fr6, pin[3], st.o[0], 0, 0, 0);
    s0[4] = __builtin_amdgcn_exp2f(s0[4]); sum += s0[4];
    s0[5] = __builtin_amdgcn_exp2f(s0[5]); sum += s0[5];
    w0[1] = cvt_pk_bf16(s0[2], s0[3]);
    asm volatile("" : "+v"(sum), "+v"(w0));
    SBAR();
    const bf16x8 fr10 = LDK(1, 0);
    if (DO_PV) st.o[1] = __builtin_amdgcn_mfma_f32_32x32x16_bf16(fr7, pin[3], st.o[1], 0, 0, 0);
    s0[6] = __builtin_amdgcn_exp2f(s0[6]); sum += s0[6];
    s0[7] = __builtin_amdgcn_exp2f(s0[7]); sum += s0[7];
    w0[2] = cvt_pk_bf16(s0[4], s0[5]);
    asm volatile("" : "+v"(sum), "+v"(w0));
    SBAR();
    if (grpB) ATT_WAITBAR_N(nis);
    const bf16x8 fr11 = LDK(1, 1);
    if (DO_QK) n0 = __builtin_amdgcn_mfma_f32_32x32x16_bf16(fr8, qr[0], st.negm, 0, 0, 0);
    s0[8] = __builtin_amdgcn_exp2f(s0[8]); sum += s0[8];
    s0[9] = __builtin_amdgcn_exp2f(s0[9]); sum += s0[9];
    w0[3] = cvt_pk_bf16(s0[6], s0[7]);
    asm volatile("" : "+v"(sum), "+v"(w0));
    SBAR();
    const bf16x8 fr12 = LDK(2, 0);
    if (DO_QK) n1 = __builtin_amdgcn_mfma_f32_32x32x16_bf16(fr9, qr[0], st.negm, 0, 0, 0);
    s0[10] = __builtin_amdgcn_exp2f(s0[10]); sum += s0[10];
    s0[11] = __builtin_amdgcn_exp2f(s0[11]); sum += s0[11];
    w1[0] = cvt_pk_bf16(s0[8], s0[9]);
    asm volatile("" : "+v"(sum), "+v"(w1));
    SBAR();
    const bf16x8 fr13 = LDK(2, 1);
    if (DO_QK) n0 = __builtin_amdgcn_mfma_f32_32x32x16_bf16(fr10, qr[1], n0, 0, 0, 0);
    s0[12] = __builtin_amdgcn_exp2f(s0[12]); sum += s0[12];
    s0[13] = __builtin_amdgcn_exp2f(s0[13]); sum += s0[13];
    w1[1] = cvt_pk_bf16(s0[10], s0[11]);
    asm volatile("" : "+v"(sum), "+v"(w1));
    SBAR();
    const bf16x8 fr14 = LDK(3, 0);
    if (DO_QK) n1 = __builtin_amdgcn_mfma_f32_32x32x16_bf16(fr11, qr[1], n1, 0, 0, 0);
    s0[14] = __builtin_amdgcn_exp2f(s0[14]); sum += s0[14];
    s0[15] = __builtin_amdgcn_exp2f(s0[15]); sum += s0[15];
    w1[2] = cvt_pk_bf16(s0[12], s0[13]);
    asm volatile("" : "+v"(sum), "+v"(w1));
    SBAR();
    const bf16x8 fr15 = LDK(3, 1);
    if (DO_QK) n0 = __builtin_amdgcn_mfma_f32_32x32x16_bf16(fr12, qr[2], n0, 0, 0, 0);
    s1[0] = __builtin_amdgcn_exp2f(s1[0]); sum += s1[0];
    s1[1] = __builtin_amdgcn_exp2f(s1[1]); sum += s1[1];
    w1[3] = cvt_pk_bf16(s0[14], s0[15]);
    asm volatile("" : "+v"(sum), "+v"(w1));
    SBAR();
    const bf16x8 fr16 = LDK(4, 0);
    if (DO_QK) n1 = __builtin_amdgcn_mfma_f32_32x32x16_bf16(fr13, qr[2], n1, 0, 0, 0);
    s1[2] = __builtin_amdgcn_exp2f(s1[2]); sum += s1[2];
    s1[3] = __builtin_amdgcn_exp2f(s1[3]); sum += s1[3];
    w2[0] = cvt_pk_bf16(s1[0], s1[1]);
    asm volatile("" : "+v"(sum), "+v"(w2));
    SBAR();
    const bf16x8 fr17 = LDK(4, 1);
    if (DO_QK) n0 = __builtin_amdgcn_mfma_f32_32x32x16_bf16(fr14, qr[3], n0, 0, 0, 0);
    s1[4] = __builtin_amdgcn_exp2f(s1[4]); sum += s1[4];
    s1[5] = __builtin_amdgcn_exp2f(s1[5]); sum += s1[5];
    w2[1] = cvt_pk_bf16(s1[2], s1[3]);
    asm volatile("" : "+v"(sum), "+v"(w2));
    SBAR();
    const bf16x8 fr18 = LDK(5, 0);
    if (DO_QK) n1 = __builtin_amdgcn_mfma_f32_32x32x16_bf16(fr15, qr[3], n1, 0, 0, 0);
    s1[6] = __builtin_amdgcn_exp2f(s1[6]); sum += s1[6];
    s1[7] = __builtin_amdgcn_exp2f(s1[7]); sum += s1[7];
    w2[2] = cvt_pk_bf16(s1[4], s1[5]);
    asm volatile("" : "+v"(sum), "+v"(w2));
    SBAR();
    const bf16x8 fr19 = LDK(5, 1);
    if (DO_QK) n0 = __builtin_amdgcn_mfma_f32_32x32x16_bf16(fr16, qr[4], n0, 0, 0, 0);
    s1[8] = __builtin_amdgcn_exp2f(s1[8]); sum += s1[8];
    s1[9] = __builtin_amdgcn_exp2f(s1[9]); sum += s1[9];
    w2[3] = cvt_pk_bf16(s1[6], s1[7]);
    asm volatile("" : "+v"(sum), "+v"(w2));
    SBAR();
    if (DO_QK) n1 = __builtin_amdgcn_mfma_f32_32x32x16_bf16(fr17, qr[4], n1, 0, 0, 0);
    s1[10] = __builtin_amdgcn_exp2f(s1[10]); sum += s1[10];
    s1[11] = __builtin_amdgcn_exp2f(s1[11]); sum += s1[11];
    w3[0] = cvt_pk_bf16(s1[8], s1[9]);
    asm volatile("" : "+v"(sum), "+v"(w3));
    SBAR();
    if (DO_QK) n0 = __builtin_amdgcn_mfma_f32_32x32x16_bf16(fr18, qr[5], n0, 0, 0, 0);
    s1[12] = __builtin_amdgcn_exp2f(s1[12]); sum += s1[12];
    s1[13] = __builtin_amdgcn_exp2f(s1[13]); sum += s1[13];
    w3[1] = cvt_pk_bf16(s1[10], s1[11]);
    asm volatile("" : "+v"(sum), "+v"(w3));
    SBAR();
    if (DO_QK) n1 = __builtin_amdgcn_mfma_f32_32x32x16_bf16(fr19, qr[5], n1, 0, 0, 0);
    s1[14] = __builtin_amdgcn_exp2f(s1[14]); sum += s1[14];
    s1[15] = __builtin_amdgcn_exp2f(s1[15]); sum += s1[15];
    w3[2] = cvt_pk_bf16(s1[12], s1[13]);
    asm volatile("" : "+v"(sum), "+v"(w3));
    SBAR();
    w3[3] = cvt_pk_bf16(s1[14], s1[15]);
    st.l = st.l * f + sum;
    pout[0] = __builtin_bit_cast(bf16x8, w0); pout[1] = __builtin_bit_cast(bf16x8, w1); pout[2] = __builtin_bit_cast(bf16x8, w2); pout[3] = __builtin_bit_cast(bf16x8, w3);
#undef LDV
#undef LDK
    return f;
}
__device__ __forceinline__ void mla_unit2(int b, int h, int qb, const bf16_t* QN, const bf16_t* QP, const bf16_t* KN, const bf16_t* KPE, const bf16_t* VM, bf16_t* O, LAS unsigned char* shm) {
    int tid = threadIdx.x; asm volatile("" : "+v"(tid));
    const int lane = tid & 63, r32 = lane & 31, hi = lane >> 5, wid = __builtin_amdgcn_readfirstlane(tid >> 6);
    const size_t rb = (size_t)b * SEQ; const int q0 = qb * 256, qrow = q0 + wid * 32 + r32, NT = (q0 + 256) / 64;
    const bf16_t* ksrc = KN + (rb + lane) * 512 + h * 64 + wid * 8;
    const bf16_t* psrc = KPE + (rb + lane) * 32 + (wid & 3) * 8;
    const bf16_t* vsrc = VM + (rb + 16 * (wid & 3) + (lane >> 2)) * 512 + h * 64 + (wid >> 2) * 32 + (lane & 3) * 8;
    const int npk = wid < 4 ? 2 : 1;
#define MLA_DMA_K(t, s) do { LAS unsigned char* sl_ = shm + (s) * MLA_KB; glds16(ksrc + (size_t)(t) * 64 * 512, sl_ + wid * 1024); if (wid < 4) glds16(psrc + (size_t)(t) * 64 * 32, sl_ + (8 + wid) * 1024); } while (0)
#define MLA_DMA_V(t, s) glds16(vsrc + (size_t)(t) * 64 * 512, shm + MLA_V0 + (s) * VB + wid * 1024)
    MLA_DMA_K(0, 0); MLA_DMA_K(1, 1);
    bf16x8 qr[6];
#pragma unroll
    for (int ks = 0; ks < 4; ++ks) qr[ks] = *(const bf16x8*)(QN + (rb + qrow) * 512 + h * 64 + ks * 16 + hi * 8);
#pragma unroll
    for (int ks = 0; ks < 2; ++ks) qr[4 + ks] = *(const bf16x8*)(QP + (rb + qrow) * 256 + h * 32 + ks * 16 + hi * 8);
    MLA_DMA_K(2, 2); MLA_DMA_V(0, 0);
    St2 st; st.m = 0.f; st.l = 0.f; st.o[0] = f32x16{}; st.o[1] = f32x16{}; st.negm = f32x16{};
    ATT_WAITBAR_N(npk + 1);
    f32x16 sa0, sa1, sb0, sb1; bf16x8 pb[4];
    { const LAS unsigned char* kb = shm + hi * 1024 + r32 * 16;
#pragma unroll
      for (int ks = 0; ks < 6; ++ks) { const bf16x8 k0 = *(const LAS bf16x8*)(kb + ks * 2048), k1 = *(const LAS bf16x8*)(kb + ks * 2048 + 512);
          if (ks == 0) { sa0 = __builtin_amdgcn_mfma_f32_32x32x16_bf16(k0, qr[0], f32x16{}, 0, 0, 0); sa1 = __builtin_amdgcn_mfma_f32_32x32x16_bf16(k1, qr[0], f32x16{}, 0, 0, 0); }
          else { sa0 = __builtin_amdgcn_mfma_f32_32x32x16_bf16(k0, qr[ks], sa0, 0, 0, 0); sa1 = __builtin_amdgcn_mfma_f32_32x32x16_bf16(k1, qr[ks], sa1, 0, 0, 0); } } }
    float fprev = 1.f; const bool grpB = wid >= 4;
#define MLA_ITER(PV, QK, I, SC0, SC1, SN0, SN1) do { const int i_ = (I); int nis = 0; \
        if (i_ + 3 < NT) { MLA_DMA_K(i_ + 3, (i_ + 3) & 3); nis += npk; } \
        if (i_ + 1 < NT) { MLA_DMA_V(i_ + 1, (i_ + 1) & 3); nis += 1; } \
        if (__any(fprev != 1.f)) { _Pragma("unroll") for (int r = 0; r < 16; ++r) { st.o[0][r] *= fprev; st.o[1][r] *= fprev; } } \
        fprev = mla_iter<PV, QK>(SC0, SC1, SN0, SN1, pb, pb, st, qr, shm + ((i_ + 1) & 3) * MLA_KB, shm + MLA_V0 + ((i_ - 1) & 3) * VB, i_ >= NT - 4, i_ == 0, grpB, nis, i_, qrow, r32, hi, lane); \
        if (!grpB) ATT_WAITBAR_N(nis); } while (0)
    MLA_ITER(false, true, 0, sa0, sa1, sb0, sb1);
    for (int i = 1; i < NT - 1; i += 2) {
        MLA_ITER(true, true, i, sb0, sb1, sa0, sa1);
        MLA_ITER(true, true, i + 1, sa0, sa1, sb0, sb1);
    }
    MLA_ITER(true, false, NT - 1, sb0, sb1, sa0, sa1);
#undef MLA_ITER
    if (__any(fprev != 1.f)) {
#pragma unroll
        for (int r = 0; r < 16; ++r) { st.o[0][r] *= fprev; st.o[1][r] *= fprev; } }
    { const LAS unsigned char* vp = shm + MLA_V0 + ((NT - 1) & 3) * VB + ((lane >> 4) & 1) * 32 + (lane & 3) * 8 + (4 * hi + ((lane & 15) >> 2)) * 64;
#pragma unroll
      for (int ks = 0; ks < 4; ++ks)
#pragma unroll
          for (int d0 = 0; d0 < 2; ++d0) { const s16x4 lo = vtr(vp + d0 * 4096 + ks * 1024), hh = vtr(vp + d0 * 4096 + ks * 1024 + 512);
              const bf16x8 v = {lo[0], lo[1], lo[2], lo[3], hh[0], hh[1], hh[2], hh[3]};
              st.o[d0] = __builtin_amdgcn_mfma_f32_32x32x16_bf16(v, pb[ks], st.o[d0], 0, 0, 0); } }
#undef MLA_DMA_K
#undef MLA_DMA_V
    float l = st.l; { auto rr = __builtin_amdgcn_permlane32_swap(__float_as_uint(l), __float_as_uint(l), false, false); l = __uint_as_float(rr[0]) + __uint_as_float(rr[1]); }
    store_o(O + (rb + qrow) * 512 + h * 64, st.o, __builtin_amdgcn_rcpf(l), hi);
    ATT_WAITBAR(0);
}
constexpr int SWA_KB = 8192, SWA_V0 = 4 * SWA_KB;
constexpr int SWA_TB_OFF = MLA_LDS, SWA_PK_OFF = SWA_TB_OFF + 16 * 132 * 4, SWA_FLG_OFF = SWA_PK_OFF + 1024, SWA_TBX_OFF = SWA_FLG_OFF + 64;
static_assert(SWA_TBX_OFF + 16 * 384 * 4 <= RING_BYTES, "attention LDS map");
static_assert(SWA_V0 + 4 * VB <= SWA_TB_OFF, "SWA band below the bias table");
__device__ __forceinline__ void swa_mask_bias(f32x16& p0, f32x16& p1, int t, int a, int pq, const LAS int* pk, const LAS float* tb, int hi) {
    const int kb = 64 * t + 4 * hi;
#pragma unroll
    for (int r = 0; r < 16; ++r) {
        const int bk0 = kb + (r & 3) + 8 * (r >> 2), bk1 = bk0 + 32;
        const int d0 = min(max(pq - pk[bk0], 0), 128), d1 = min(max(pq - pk[bk1], 0), 128);
        p0[r] = (bk0 > a && bk0 <= a + 128) ? p0[r] + tb[d0] : -INFINITY;
        p1[r] = (bk1 > a && bk1 <= a + 128) ? p1[r] + tb[d1] : -INFINITY; }
}
__device__ __forceinline__ void swa_mask_bias_contig(f32x16& p0, f32x16& p1, int t, int a, const LAS float* tbx, int hi) {
    const int db = 128 + a - 64 * t - 4 * hi; const LAS float* tp = tbx + (128 + db - 59);
#pragma unroll
    for (int r = 0; r < 16; ++r) { const int cr = (r & 3) + 8 * (r >> 2); p0[r] += tp[59 - cr]; p1[r] += tp[27 - cr]; }
}
__device__ __forceinline__ void swa_unit(int b, int n, int kvh, const bf16_t* QS, const bf16_t* KS, const bf16_t* VS, bf16_t* O, const int* pos, const float* sinks, LAS unsigned char* shm) {
    int tid = threadIdx.x; asm volatile("" : "+v"(tid));
    const int lane = tid & 63, r32 = lane & 31, hi = lane >> 5, wid = __builtin_amdgcn_readfirstlane(tid >> 6);
    const size_t rb = (size_t)b * SEQ; const int a0 = (wid & 3) * 32, a = a0 + r32, qrow = n * 128 + a;
    const int kt0 = n == 0 ? 2 : 0; const long band0 = (long)rb + n * 128 - 128;
    const bf16_t* ksrc = KS + (band0 + lane) * 128 + kvh * 64 + wid * 8;
    const bf16_t* vsrc = VS + (band0 + 16 * (wid & 3) + (lane >> 2)) * 128 + kvh * 64 + (wid >> 2) * 32 + (lane & 3) * 8;
    for (int t = kt0; t < 4; ++t) { glds16(ksrc + (long)t * 64 * 128, shm + t * SWA_KB + wid * 1024); glds16(vsrc + (long)t * 64 * 128, shm + SWA_V0 + t * VB + wid * 1024); }
    LAS int* pk = (LAS int*)(shm + SWA_PK_OFF); LAS int* flg = (LAS int*)(shm + SWA_FLG_OFF);
    if (tid < 256) { const long r = band0 + tid; const bool valid = r >= (long)rb; const int p = valid ? pos[r] : 0; pk[tid] = p;
        const bool ok = !valid || (p - tid == pos[rb + n * 128] - 128); const bool all = __all(ok); if (lane == 0) flg[wid] = all ? 1 : 0; }
    const int pq = pos[rb + qrow];
    const int tlo = a0 >= 64 ? (kt0 > 1 ? kt0 : 1) : kt0, thi = a0 >= 64 ? 3 : 2;
    const bf16_t* qsrc = QS + (rb + qrow) * 1024 + (kvh * 8 + (wid >> 2)) * 64 + hi * 8;
    bf16x8 qn[4];
#pragma unroll
    for (int ks = 0; ks < 4; ++ks) qn[ks] = *(const bf16x8*)(qsrc + ks * 16);
    ATT_WAITBAR(0);
    const bool contig = __builtin_amdgcn_readfirstlane(flg[0] & flg[1] & flg[2] & flg[3]) != 0;
    const unsigned lds0 = (unsigned)(uintptr_t)shm, klane = lds0 + hi * 1024 + r32 * 16, vlane = lds0 + SWA_V0 + ((lane >> 4) & 1) * 32 + (lane & 3) * 8 + (4 * hi + ((lane & 15) >> 2)) * 64;
    for (int hp = 0; hp < 4; ++hp) {
        const int head = kvh * 8 + 2 * hp + (wid >> 2);
        bf16x8 qr[4];
#pragma unroll
        for (int ks = 0; ks < 4; ++ks) qr[ks] = qn[ks];
        if (hp < 3) {
#pragma unroll
            for (int ks = 0; ks < 4; ++ks) qn[ks] = *(const bf16x8*)(qsrc + (hp + 1) * 128 + ks * 16);
        }
        const LAS float* tb = (const LAS float*)(shm + SWA_TB_OFF) + head * 132; const LAS float* tbx = (const LAS float*)(shm + SWA_TBX_OFF) + head * 384;
        State st; st.m = sinks[head] * LOG2E; st.o[0] = f32x16{}; st.o[1] = f32x16{};
#pragma unroll
        for (int r = 0; r < 16; ++r) { st.negm[r] = -st.m; st.lacc[r] = 1.f; }
        bf16x8 kf[8]; k_issue<4>(kf, klane + tlo * SWA_KB);
        for (int t = tlo; t <= thi; ++t) {
            s16x4 vf[8], vg[8]; bf16x8 pa[4]; f32x16 c0, c1;
            v_issue(vf, vlane + t * VB);
            SBAR();
            k_wait8_4(kf);
            SBAR();
            v_issue(vg, vlane + t * VB + 4096);
            SBAR();
            qk_mma<4>(c0, c1, kf, qr, st.negm);
            if (contig) swa_mask_bias_contig(c0, c1, t, a, tbx, hi); else swa_mask_bias(c0, c1, t, a, pq, pk, tb, hi);
            decide(c0, c1, false, st);
            exp_pack(c0, c1, pa);
            SBAR();
            if (t < thi) k_issue<4>(kf, klane + (t + 1) * SWA_KB);
            SBAR();
            if (t < thi) { v_wait8(vf); v_wait8(vg); } else { v_wait(vf); v_wait(vg); }
            SBAR();
            pv_mma<true>(st.o[0], st.lacc, vf, pa);
            pv_mma<false>(st.o[1], st.lacc, vg, pa);
        }
        store_o(O + (rb + qrow) * 1024 + head * 64, st.o, __builtin_amdgcn_rcpf(st.lacc[0]), hi);
    }
    ATT_WAITBAR(0);
}
}

#define XB_TMO      128
#define XB_XCNT(j)  (256  + 64 * (j))
#define XB_XSUB(j)  (1280 + 64 * (j))
#define XB_XGEN(j)  (2304 + 64 * (j))
#define XB_TOP      3328
#define XB_TOPGEN   3392
#define XCD_BAR_WORDS 3456
#define XB_SPIN_CAP (1u << 18)
__device__ __forceinline__ unsigned xb_ld(unsigned* p)              { return __hip_atomic_load(p, __ATOMIC_RELAXED, __HIP_MEMORY_SCOPE_AGENT); }
__device__ __forceinline__ unsigned xb_add(unsigned* p, unsigned v) { return __hip_atomic_fetch_add(p, v, __ATOMIC_RELAXED, __HIP_MEMORY_SCOPE_AGENT); }
__device__ __forceinline__ unsigned xb_xcc_id() { return (unsigned)__builtin_amdgcn_s_getreg((3 << 11) | 20) & 0xFu; }
#define XB_SPIN(cond, bar) do { unsigned _sp = 0; while (cond) { __builtin_amdgcn_s_sleep(1); \
    if ((++_sp & 255u) == 0u) { if (xb_ld(&(bar)[XB_TMO])) break; if (_sp > XB_SPIN_CAP) { atomicAdd(&(bar)[XB_TMO], 1u); break; } } } } while (0)
#define XB_EARLY_INV() asm volatile("buffer_inv sc1" ::: "memory")
struct XcdBarrier { unsigned* bar; unsigned x; volatile LAS unsigned* st; };
__device__ __forceinline__ XcdBarrier xcd_barrier_post(unsigned* bar, volatile LAS unsigned* st) {
    XcdBarrier b; b.bar = bar; b.x = xb_xcc_id(); b.st = st;
    if (threadIdx.x == 0) st[2] = xb_add(&bar[XB_XCNT(b.x)], 1u);
    return b;
}
__device__ __forceinline__ void xcd_barrier_complete(unsigned* bar, unsigned x, unsigned& nloc, unsigned& nx) {
    const unsigned G = gridDim.x * gridDim.y * gridDim.z;
    unsigned sum, cnt, mine, sp = 0u;
    for (;;) {
        sum = 0u; cnt = 0u; mine = 0u;
#pragma unroll
        for (unsigned j = 0; j < 16; ++j) { const unsigned c = xb_ld(&bar[XB_XCNT(j)]); sum += c; cnt += (c > 0u) ? 1u : 0u; mine = (j == x) ? c : mine; }
        if (sum == G) break;
        __builtin_amdgcn_s_sleep(1);
        if ((++sp & 255u) == 0u) { if (xb_ld(&bar[XB_TMO])) break; if (sp > XB_SPIN_CAP) { atomicAdd(&bar[XB_TMO], 1u); break; } }
    }
    nloc = mine > 0u ? mine : 1u; nx = cnt > 0u ? cnt : 1u;
}
__device__ __forceinline__ void xcd_barrier(const XcdBarrier& b) {
    asm volatile("s_waitcnt vmcnt(0)" ::: "memory");
    __syncthreads();
    if (threadIdx.x == 0) {
        unsigned* bar = b.bar;
        __builtin_amdgcn_s_waitcnt(0);
        unsigned nloc = b.st[0], nx = b.st[1];
        if (nloc == 0u) { xcd_barrier_complete(bar, b.x, nloc, nx); b.st[0] = nloc; b.st[1] = nx; }
        const unsigned old = xb_add(&bar[XB_XSUB(b.x)], 1u);
        const unsigned gen = old / nloc;
        if (old + 1u == (gen + 1u) * nloc) {
            __builtin_amdgcn_fence(__ATOMIC_RELEASE, "agent");
            asm volatile("s_waitcnt vmcnt(0)" ::: "memory");
            const unsigned og = xb_add(&bar[XB_TOP], 1u);
            const unsigned tg = og / nx;
            if (og + 1u == (tg + 1u) * nx) xb_add(&bar[XB_TOPGEN], 1u);
            else XB_SPIN(xb_ld(&bar[XB_TOPGEN]) == tg, bar);
            __builtin_amdgcn_fence(__ATOMIC_ACQUIRE, "agent");
            xb_add(&bar[XB_XGEN(b.x)], 1u);
            asm volatile("s_waitcnt vmcnt(0)" ::: "memory");
        } else {
            XB_EARLY_INV();
            XB_SPIN(xb_ld(&bar[XB_XGEN(b.x)]) == gen, bar);
            asm volatile("s_waitcnt vmcnt(0)" ::: "memory");
        }
    }
    __syncthreads();
}

#define XT_CNT(t)  (XCD_BAR_WORDS + 2048 + 64 * (t))
#define XT_GEN(t)  (XCD_BAR_WORDS + 2048 + 4096 + 64 * (t))
__device__ __forceinline__ void team_barrier(const XcdBarrier& b) {
    asm volatile("s_waitcnt vmcnt(0)" ::: "memory");
    __syncthreads();
    if (threadIdx.x == 0) {
        unsigned* bar = b.bar; const unsigned c = b.st[4], team = ((c & 7u) << 3) | ((c >> 3) & 7u);
        const unsigned old = xb_add(&bar[XT_CNT(team)], 1u);
        XB_EARLY_INV();
        const unsigned gen = old >> 2;
        if ((old & 3u) == 3u) xb_add(&bar[XT_GEN(team)], 1u);
        else XB_SPIN(xb_ld(&bar[XT_GEN(team)]) == gen, bar);
        asm volatile("s_waitcnt vmcnt(0)" ::: "memory");
    }
    __syncthreads();
}
#define XD_CNT(t)  (XCD_BAR_WORDS + 2048 + 8192 + 64 * (t))
#define XD_GEN(t)  (XCD_BAR_WORDS + 2048 + 8192 + 2048 + 64 * (t))
__device__ __forceinline__ void pair_barrier(const XcdBarrier& b) {
    asm volatile("s_waitcnt vmcnt(0)" ::: "memory");
    __syncthreads();
    if (threadIdx.x == 0) {
        unsigned* bar = b.bar; const unsigned c = b.st[4], dt = ((c & 7u) << 2) | ((c >> 4) & 3u);
        const unsigned old = xb_add(&bar[XD_CNT(dt)], 1u);
        XB_EARLY_INV();
        const unsigned gen = old >> 3;
        if ((old & 7u) == 7u) xb_add(&bar[XD_GEN(dt)], 1u);
        else XB_SPIN(xb_ld(&bar[XD_GEN(dt)]) == gen, bar);
        asm volatile("s_waitcnt vmcnt(0)" ::: "memory");
    }
    __syncthreads();
}
__device__ __forceinline__ void chain_setup(const XcdBarrier& b) {
    if (threadIdx.x == 0) {
        const unsigned G = gridDim.x; unsigned slot = 0, nx = 0; bool uni = (G % 8u) == 0u;
#pragma unroll
        for (unsigned j = 0; j < 16; ++j) { const unsigned c = xb_ld(&b.bar[XB_XCNT(j)]); if (c) { ++nx; if (c != G / 8u) uni = false; if (j < b.x) ++slot; } }
        const bool ok = uni && nx == 8u && G == 256u && b.st[2] < G / 8u;
        b.st[3] = ok ? 1u : 0u; b.st[4] = ok ? b.st[2] * 8u + slot : blockIdx.x;
    }
    __syncthreads();
}
struct TailFinal {
    float* out; const float* ssq2; const float* gfin; XcdBarrier bar; bool fuse, local;
    __device__ __forceinline__ void operator()(EPI_ARGS) const {
        if (!fuse) return;
        if (local) team_barrier(bar); else xcd_barrier(bar);
        const int row0 = u.pm * 256 + wr * 64 + fr, c0 = u.pn * 256 + wc * 32 + fq * 8;
        f32x4 gf[2][2];
        FOR_BJ_N gf[bj][n] = *(const f32x4*)(gfin + c0 + bj * 128 + n * 4);
        FOR_AI_M { const int row = row0 + ai * 128 + m * 16; const float rs = __builtin_amdgcn_rsqf(ld_agent(ssq2 + row) * (1.f / 1024.f) + EPS);
            FOR_BJ_N __builtin_nontemporal_store(acc[ai][bj][m][n] * rs * gf[bj][n], (f32x4*)(out + (size_t)row * 1024 + c0 + bj * 128 + n * 4)); }
    }
};
__device__ __forceinline__ float wave_sum(float v) {
#pragma unroll
    for (int o = 1; o < 64; o <<= 1) v += __shfl_xor(v, o);
    return v;
}
__device__ __forceinline__ int ropepos(int d) { return 8 * ((d >> 2) & 3) + 4 * (d >> 4) + (d & 3); }
template <int MAP> __device__ __forceinline__ int wmap(int n) {
    if (MAP == 1) { if (n >= 384 && n < 416) return 384 + ropepos(n - 384); if (n < 416) return n; if (n < 1696) return n + 96;
        const int g = n - 1696, c = g & 1023; return 1792 + (c >> 7) * 256 + (g >> 10) * 128 + (c & 127); }
    if (MAP == 2) { const int h = n / 96, d = n - h * 96; return d < 64 ? h * 64 + d : 512 + h * 32 + ropepos(d - 64); }
    if (MAP == 3) { const int h = n >> 7, d = n & 127; return d < 64 ? h * 64 + d : 512 + h * 64 + (d - 64); }
    return n;
}
template <int MAP, bool TILED = false> __device__ __forceinline__ void transpose_item(const float* W, int K, int N, bf16_t* WT, const float* rs, LAS float* scr, int item, int lane) {
    const int nblk = N / 32, kb = item / nblk, nb = item % nblk, k0 = 64 * kb, n0 = 32 * nb;
    float wv[32];
#pragma unroll
    for (int i = 0; i < 32; ++i) wv[i] = __builtin_nontemporal_load(W + (size_t)(k0 + 2 * i + (lane >> 5)) * N + n0 + (lane & 31));
#pragma unroll
    for (int i = 0; i < 32; ++i) { const int kk = 2 * i + (lane >> 5); float v = wv[i]; if (rs) v *= rs[k0 + kk]; scr[kk * 33 + (lane & 31)] = v; }
    asm volatile("s_waitcnt lgkmcnt(0)" ::: "memory");
    const int c = lane & 7;
#pragma unroll
    for (int j = 0; j < 4; ++j) { const int n = (lane >> 3) + 8 * j; const LAS float* s = scr + (8 * c) * 33 + n;
        u32x4 o; o.x = pk2(s[0 * 33], s[1 * 33]); o.y = pk2(s[2 * 33], s[3 * 33]); o.z = pk2(s[4 * 33], s[5 * 33]); o.w = pk2(s[6 * 33], s[7 * 33]);
        const int nn = wmap<MAP>(n0 + n);
        if (TILED) *(u32x4*)(WT + ((size_t)((nn >> 8) * (K >> 6) + kb) * 256 + (nn & 255)) * 64 + 8 * c) = o;
        else *(u32x4*)(WT + (size_t)nn * K + k0 + 8 * c) = o; }
    asm volatile("s_waitcnt lgkmcnt(0)" ::: "memory");
}
__device__ const float ROPE_INV[16] = {1.0f, 0.5623413251903491f, 0.31622776601683794f, 0.1778279410038923f, 0.1f, 0.05623413251903491f, 0.03162277660168379f, 0.01778279410038923f,
    0.01f, 0.005623413251903491f, 0.0031622776601683794f, 0.0017782794100389228f, 0.001f, 0.0005623413251903491f, 0.00031622776601683794f, 0.00017782794100389227f};

struct Args { const void* in[21]; float* out; unsigned char* ws; };
__device__ __forceinline__ int otid() { int t = threadIdx.x; asm volatile("" : "+v"(t)); return t; }
#define PHASE_IDS const int tid = otid(), lane = tid & 63, wave = __builtin_amdgcn_readfirstlane(tid >> 6), gw = vcu * NWAVES + wave; (void)lane; (void)gw

__global__ void __launch_bounds__(NWAVES * 64, 2) fwd_mega(Args args) {
    extern __shared__ __attribute__((aligned(16))) unsigned char lds_raw[];
    LAS unsigned char* lds = (LAS unsigned char*)lds_raw;
    volatile LAS unsigned* MISC = (volatile LAS unsigned*)(lds + MISC_OFF);
    const int G = gridDim.x, bx = blockIdx.x, vcu = (G % 8 == 0) ? (bx % 8) * (G / 8) + bx / 8 : bx;
    const int NGW = G * NWAVES;
    unsigned char* ws = args.ws;
    const float* x = (const float*)args.in[0]; const float* cvec = (const float*)args.in[1]; const int* pos = (const int*)args.in[2]; const float* rel_bias = (const float*)args.in[3];
    const float* ada_w = (const float*)args.in[4]; const float* ada_b = (const float*)args.in[5]; const float* ln_mix_g = (const float*)args.in[6]; const float* w_in = (const float*)args.in[7];
    const float* b_gate = (const float*)args.in[8]; const float* g_q = (const float*)args.in[9]; const float* g_kv = (const float*)args.in[10]; const float* w_uq = (const float*)args.in[11];
    const float* w_ukv = (const float*)args.in[12]; const float* sinks = (const float*)args.in[13]; const float* w_o_mla = (const float*)args.in[14]; const float* w_o_swa = (const float*)args.in[15];
    const float* w_o = (const float*)args.in[16]; const float* ln_mlp_g = (const float*)args.in[17]; const float* w_ff1 = (const float*)args.in[18]; const float* w_ff2 = (const float*)args.in[19];
    const float* ln_final_g = (const float*)args.in[20];
    float* out = args.out;
    unsigned* ctl = (unsigned*)(ws + WS_CTL);
    float* ssq_q = (float*)(ws + CTL_SSQ_Q); float* ssq_kv = (float*)(ws + CTL_SSQ_KV); float* ssq1 = (float*)(ws + CTL_SSQ1); float* ssq2 = (float*)(ws + CTL_SSQ2);
    bf16_t* Win_t = (bf16_t*)(ws + WS_WIN); bf16_t* Wuq_t = (bf16_t*)(ws + WS_WUQ); bf16_t* Wukv_t = (bf16_t*)(ws + WS_WUKV); bf16_t* Womla_t = (bf16_t*)(ws + WS_WOMLA);
    bf16_t* Woswa_t = (bf16_t*)(ws + WS_WOSWA); bf16_t* Wo_t = (bf16_t*)(ws + WS_WO); bf16_t* W1_t = (bf16_t*)(ws + WS_W1); bf16_t* W2_t = (bf16_t*)(ws + WS_W2);
    float* mod = (float*)(ws + WS_MOD); float* bias2 = (float*)(ws + WS_BIAS2); float* tbg = (float*)(ws + WS_TB);
    bf16_t* QN = (bf16_t*)(ws + WS_QN); bf16_t* QP = (bf16_t*)(ws + WS_QP); bf16_t* KN = (bf16_t*)(ws + WS_KN); bf16_t* VM = (bf16_t*)(ws + WS_VM);
    float* cs = (float*)(ws + WS_CS); float* sn = (float*)(ws + WS_SN); bf16_t* A2 = (bf16_t*)(ws + WS_A2); bf16_t* X1B = (bf16_t*)(ws + WS_X1B);
    bf16_t* QS = (bf16_t*)(ws + WS_QS); bf16_t* GA = (bf16_t*)(ws + WS_GA); bf16_t* GB = (bf16_t*)(ws + WS_GB); bf16_t* QLAT = (bf16_t*)(ws + WS_QLAT); bf16_t* KVLAT = (bf16_t*)(ws + WS_KVLAT);
    bf16_t* KPE = (bf16_t*)(ws + WS_KPE); bf16_t* KS = (bf16_t*)(ws + WS_KS); bf16_t* VS = (bf16_t*)(ws + WS_VS); bf16_t* U = (bf16_t*)(ws + WS_U);
    bf16_t* YMLA = QN; bf16_t* YSWA = QS;
    bf16_t* H = (bf16_t*)(ws + WS_H); bf16_t* MERGED = (bf16_t*)(ws + WS_MERGED);

    { PHASE_IDS; for (int i = tid; i < (LDS_BYTES - LDSCTL_OFF) / 4; i += NWAVES * 64) ((LAS unsigned*)(lds + LDSCTL_OFF))[i] = 0u; }
    __syncthreads();
    { PHASE_IDS; unsigned* flag = ctl + CW_FLAG;
      if (bx == 0) { if (tid < 278) __hip_atomic_store(ctl + CW_BAR + 64 * tid, 0u, __ATOMIC_RELAXED, __HIP_MEMORY_SCOPE_AGENT);
          asm volatile("s_waitcnt vmcnt(0)" ::: "memory"); __syncthreads();
          if (tid == 0) __hip_atomic_store(flag, CTL_READY, __ATOMIC_RELAXED, __HIP_MEMORY_SCOPE_AGENT); }
      if (tid == 0) { unsigned sp = 0; while (xb_ld(flag) != CTL_READY && ++sp < (1u << 22)) __builtin_amdgcn_s_sleep(1); }
      __syncthreads(); }
    XcdBarrier bar = xcd_barrier_post(ctl + CW_BAR, MISC + 8);
    __syncthreads();
    const int spec_cx = (bar.x < 8u && MISC[8 + 2] < 32u && gridDim.x == 256u) ? (int)(MISC[8 + 2] * 8u + bar.x) : -1;
    f32x4 pfx[8][4];
    { PHASE_IDS; (void)gw; const int rb_ = spec_cx >= 0 ? (spec_cx & 7) * 2048 + ((spec_cx >> 3) & 7) * 256 + (spec_cx >> 6) * 64 + wave * 8 : 0;
#pragma unroll
      for (int q = 0; q < 8; ++q) { const f32x4* xr = (const f32x4*)(x + (size_t)(rb_ + q) * 1024) + lane;
#pragma unroll
          for (int j = 0; j < 4; ++j) pfx[q][j] = __builtin_nontemporal_load(xr + 64 * j); } }

    for (int strip = vcu; strip < 192; strip += G) {
        PHASE_IDS;
        LAS float* sl = (LAS float*)lds; LAS float* part = (LAS float*)(lds + 16384);
        for (int i = tid; i < 4096; i += 512) { const float v = cvec[i]; sl[i] = v / (1.f + __expf(-v)); }
        __syncthreads();
        const int n0 = strip * 32, c4 = lane & 7, kr = lane >> 3;
        const float* Wp = ada_w + (size_t)(128 * wave + kr) * 6144 + n0 + 4 * c4;
        f32x4 wv[16];
#pragma unroll
        for (int i = 0; i < 16; ++i) wv[i] = __builtin_nontemporal_load((const f32x4*)(Wp + (size_t)8 * i * 6144));
        f32x4 a0 = {0.f, 0.f, 0.f, 0.f}, a1 = a0, a2 = a0, a3 = a0;
#pragma unroll
        for (int i = 0; i < 16; ++i) { const int k = 128 * wave + 8 * i + kr; a0 += wv[i] * sl[k]; a1 += wv[i] * sl[1024 + k]; a2 += wv[i] * sl[2048 + k]; a3 += wv[i] * sl[3072 + k]; }
#pragma unroll
        for (int o = 8; o < 64; o <<= 1)
#pragma unroll
            for (int j = 0; j < 4; ++j) { a0[j] += __shfl_xor(a0[j], o); a1[j] += __shfl_xor(a1[j], o); a2[j] += __shfl_xor(a2[j], o); a3[j] += __shfl_xor(a3[j], o); }
        if (lane < 8) { *(LAS f32x4*)(part + (wave * 4 + 0) * 32 + 4 * c4) = a0; *(LAS f32x4*)(part + (wave * 4 + 1) * 32 + 4 * c4) = a1; *(LAS f32x4*)(part + (wave * 4 + 2) * 32 + 4 * c4) = a2; *(LAS f32x4*)(part + (wave * 4 + 3) * 32 + 4 * c4) = a3; }
        __syncthreads();
        if (tid < 128) { const int b = tid >> 5, c = tid & 31; float s = 0.f;
#pragma unroll
            for (int w = 0; w < 8; ++w) s += part[(w * 4 + b) * 32 + c];
            mod[b * 6144 + n0 + c] = s + ada_b[n0 + c]; }
        __syncthreads();
    }
    {
        PHASE_IDS;
        LAS float* scr = (LAS float*)(lds + wave * 16384);
        constexpr int I_WIN = 16 * 117, I_WUQ = 4 * 24, I_WUKV = 2 * 32;
        constexpr int NITEMS = I_WIN + I_WUQ + I_WUKV;
        for (int it = gw; it < NITEMS; it += NGW) {
            int r = it;
            if (r < I_WIN) { transpose_item<1>(w_in, 1024, 3744, Win_t, nullptr, scr, r, lane); continue; } r -= I_WIN;
            if (r < I_WUQ) { transpose_item<2>(w_uq, 256, 768, Wuq_t, g_q, scr, r, lane); continue; } r -= I_WUQ;
            transpose_item<3>(w_ukv, 128, 1024, Wukv_t, g_kv, scr, r, lane);
        }
        { const int nfree = G > 192 ? G - 192 : G, fi = G > 192 ? vcu - 192 : vcu;
          if (fi >= 0) { constexpr int I_WOMLA = 8 * 32, I_WOSWA = 16 * 32, I_WO = 16 * 32;
            for (int it = fi * NWAVES + wave; it < I_WOMLA + I_WOSWA + I_WO; it += nfree * NWAVES) {
                int r = it;
                if (r < I_WOMLA) { transpose_item<0>(w_o_mla, 512, 1024, Womla_t, nullptr, scr, r, lane); continue; } r -= I_WOMLA;
                if (r < I_WOSWA) { transpose_item<0>(w_o_swa, 1024, 1024, Woswa_t, nullptr, scr, r, lane); continue; } r -= I_WOSWA;
                transpose_item<0>(w_o, 1024, 1024, Wo_t, nullptr, scr, r, lane);
            } } }
        const int gt = vcu * 512 + tid, NGT = G * 512;
        for (int i = gt; i < 96 * 1024 / 8; i += NGT) *(u32x4*)(Win_t + (size_t)416 * 1024 + (size_t)i * 8) = (u32x4){0u, 0u, 0u, 0u};
        for (int i = gt; i < M * 16; i += NGT) { const int mrow = i >> 4, fi = i & 15; const float ang = (float)pos[mrow] * ROPE_INV[fi];
            double t = (double)ang * 0.15915494309189535; t -= floor(t); const float f = (float)t; cs[i] = __builtin_amdgcn_cosf(f); sn[i] = __builtin_amdgcn_sinf(f); }
        for (int i = gt; i < 4 * M; i += NGT) __hip_atomic_store((unsigned*)(ws + CTL_SSQ_Q) + i, 0u, __ATOMIC_RELAXED, __HIP_MEMORY_SCOPE_AGENT);
        for (int i = gt; i < 16 * 132; i += NGT) { const int hh = i / 132, rel = i - hh * 132; int bkt = rel;
            if (rel >= 16) { const float v = __logf((float)rel * (1.f / 16.f)) * (16.f / 2.0794415416798357f); bkt = 16 + (int)v; if (bkt > 31) bkt = 31; }
            tbg[i] = rel_bias[hh * 32 + bkt] * LOG2E; }
    }
    xcd_barrier(bar);
    if (bx == 0 && threadIdx.x == 0) __hip_atomic_store(ctl + CW_FLAG, 0u, __ATOMIC_RELAXED, __HIP_MEMORY_SCOPE_AGENT);
    chain_setup(bar);
#define chain_local (__builtin_amdgcn_readfirstlane((int)MISC[8 + 3]) != 0)
#define cx __builtin_amdgcn_readfirstlane((int)MISC[8 + 4])

#define P1A_ROW(V, mrow) do { const float* mb = mod + (size_t)((mrow) >> 12) * 6144; float s_ = 0.f; \
        _Pragma("unroll") for (int j = 0; j < 4; ++j) s_ += (V[j][0] * V[j][0] + V[j][1] * V[j][1]) + (V[j][2] * V[j][2] + V[j][3] * V[j][3]); \
        const float rstd_ = __builtin_amdgcn_rsqf(wave_sum(s_) * (1.f / 1024.f) + EPS); \
        _Pragma("unroll") for (int j = 0; j < 4; ++j) { const int c = 4 * lane + 256 * j; const f32x4 g = *(const f32x4*)(ln_mix_g + c), sh = *(const f32x4*)(mb + c), sc = *(const f32x4*)(mb + 1024 + c); \
            *(u32x2*)(H + (size_t)(mrow) * 1024 + c) = pack4(V[j] * rstd_ * g * (sc + 1.f) + sh); } } while (0)
    { PHASE_IDS;
    const bool loc = chain_local;
    if (loc && cx == spec_cx) {
        const int rbase = (cx & 7) * 2048 + ((cx >> 3) & 7) * 256 + (cx >> 6) * 64 + wave * 8;
#pragma unroll
        for (int q = 0; q < 8; ++q) P1A_ROW(pfx[q], rbase + q);
    } else {
    const int rbase = loc ? (cx & 7) * 2048 + ((cx >> 3) & 7) * 256 + (cx >> 6) * 64 + wave * 8 : gw, rstep = loc ? 1 : NGW, ngrp = loc ? 2 : (M + 4 * NGW - 1) / (4 * NGW);
    for (int gi = 0; gi < ngrp; ++gi) { const int mrow0 = rbase + gi * 4 * rstep;
        f32x4 v[4][4];
#pragma unroll
        for (int q = 0; q < 4; ++q) { const int mrow = mrow0 + q * rstep; if (mrow < M) { const f32x4* xr = (const f32x4*)(x + (size_t)mrow * 1024) + lane;
#pragma unroll
            for (int j = 0; j < 4; ++j) v[q][j] = __builtin_nontemporal_load(xr + 64 * j); } }
#pragma unroll
        for (int q = 0; q < 4; ++q) { const int mrow = mrow0 + q * rstep; if (mrow < M) P1A_ROW(v[q], mrow); }
    }
    }
    }
    if (chain_local) team_barrier(bar); else xcd_barrier(bar);

    {
        pg8::Gemm g{H, Win_t, M, NIN, 1024, nullptr, nullptr, 0}; const int cP1 = cx; pg8::StaticOrder S; S.init(M, NIN, G, cP1);
        EpiP1 E{QLAT, KVLAT, KPE, QS, KS, VS, GA, GB, ssq_q, ssq_kv, cs, sn, b_gate};
        pg8::gemm_phase<EpiP1, true>(lds, g, S, E);
        PHASE_IDS;
        const int nwg = (M / 256) * (NIN / 256), rem = nwg % G, nlight = rem ? G - rem : G, li = rem ? cP1 - rem : cP1;
        if (li >= 0) {
            LAS float* scr = (LAS float*)(lds + wave * 16384);
            constexpr int I_W1 = 16 * 128, I_W2 = 64 * 32, NIT = I_W1 + I_W2;
            for (int it = li * NWAVES + wave; it < NIT; it += nlight * NWAVES) {
                if (it < I_W1) transpose_item<0, true>(w_ff1, 1024, 4096, W1_t, nullptr, scr, it, lane);
                else transpose_item<0, true>(w_ff2, 4096, 1024, W2_t, nullptr, scr, it - I_W1, lane);
            }
        }
    }
    if (chain_local) team_barrier(bar); else xcd_barrier(bar);

    {
        pg8::Gemm g{QLAT, Wuq_t, M, 768, 256, nullptr, nullptr, 0}; pg8::StaticOrder S; S.init(M, 768, G, cx);
        EpiQ E{QN, QP, ssq_q, cs, sn};
        pg8::gemm_phase<EpiQ, true>(lds, g, S, E);
    }
    { PHASE_IDS; const int nb2 = G > 192 ? G - 192 : G, bi = G > 192 ? cx - 192 : cx;
      if (bi >= 0) {
        LAS float* part = (LAS float*)lds;
        float shv[4][2];
#pragma unroll
        for (int b = 0; b < 4; ++b) { shv[b][0] = mod[(size_t)b * 6144 + 3 * 1024 + 128 * wave + lane]; shv[b][1] = mod[(size_t)b * 6144 + 3 * 1024 + 128 * wave + 64 + lane]; }
        for (int cb = bi; cb < 64; cb += nb2) {
            const float* wp = w_ff1 + (size_t)(128 * wave) * 4096 + cb * 64 + lane;
            float a0 = 0.f, a1 = 0.f, a2 = 0.f, a3 = 0.f;
#pragma unroll
            for (int kk = 0; kk < 128; kk += 32) {
                float wv[32];
#pragma unroll
                for (int i = 0; i < 32; ++i) wv[i] = __builtin_nontemporal_load(wp + (size_t)(kk + i) * 4096);
#pragma unroll
                for (int i = 0; i < 32; ++i) { const int hf = (kk + i) >> 6, l = (kk + i) & 63;
                    a0 += wv[i] * __builtin_bit_cast(float, __builtin_amdgcn_readlane(__builtin_bit_cast(int, shv[0][hf]), l)); a1 += wv[i] * __builtin_bit_cast(float, __builtin_amdgcn_readlane(__builtin_bit_cast(int, shv[1][hf]), l));
                    a2 += wv[i] * __builtin_bit_cast(float, __builtin_amdgcn_readlane(__builtin_bit_cast(int, shv[2][hf]), l)); a3 += wv[i] * __builtin_bit_cast(float, __builtin_amdgcn_readlane(__builtin_bit_cast(int, shv[3][hf]), l)); }
            }
            part[(wave * 4 + 0) * 64 + lane] = a0; part[(wave * 4 + 1) * 64 + lane] = a1; part[(wave * 4 + 2) * 64 + lane] = a2; part[(wave * 4 + 3) * 64 + lane] = a3;
            __syncthreads();
            if (tid < 256) { float sum = 0.f;
#pragma unroll
                for (int w = 0; w < 8; ++w) sum += part[(w * 4 + (tid >> 6)) * 64 + (tid & 63)];
                bias2[(size_t)(tid >> 6) * 4096 + cb * 64 + (tid & 63)] = sum; }
            __syncthreads();
        }
      }
    }
    {
        pg8::Gemm g{KVLAT, Wukv_t, M, 1024, 128, nullptr, nullptr, 0}; pg8::StaticOrder S; S.init(M, 1024, G, cx);
        EpiKV E{KN, VM, ssq_kv};
        pg8::gemm_phase<EpiKV, true>(lds, g, S, E);
    }
    xcd_barrier(bar);

    {
        { PHASE_IDS; LAS float* tb = (LAS float*)(lds + att::SWA_TB_OFF); for (int i = tid; i < 16 * 132; i += 512) tb[i] = tbg[i];
          LAS float* tbx = (LAS float*)(lds + att::SWA_TBX_OFF); for (int i = tid; i < 16 * 384; i += 512) { const int hh = i / 384, d = i - hh * 384 - 128; tbx[i] = (d >= 0 && d < 128) ? tbg[hh * 132 + d] : -INFINITY; } }
        __syncthreads();
        for (int mu = cx; mu < 256; mu += G) {
            const int b = (mu & 7) >> 1, j = mu & 1, r = mu >> 3, p = r & 7, u8 = 4 * (p & 1) + (r >> 3), s = 4 * j + (p >> 1);
            att::mla_unit2(b, u8, 15 - s, QN, QP, KN, KPE, VM, YMLA, lds);
            att::mla_unit2(b, u8, s, QN, QP, KN, KPE, VM, YMLA, lds);
        }
        for (int su = cx; su < 256; su += G) {
            const int b = (su & 7) >> 1, j = su & 1, r = su >> 3, p = r & 7, u8 = 4 * (p & 1) + (r >> 3), qb = pg8::pair_qb(8 * j + (p & 6) + (u8 >> 2));
            att::swa_unit(b, 2 * qb + ((u8 >> 1) & 1), u8 & 1, QS, KS, VS, YSWA, pos, sinks, lds); }
    }
    if (chain_local) pair_barrier(bar); else xcd_barrier(bar);

    {
        pg8::Gemm g{YMLA, Womla_t, M, 1024, 512, YSWA, Woswa_t, 1024}; pg8::StaticOrder S; S.init(M, 1024, G, cx, true);
        EpiMerge E{GA, GB, MERGED};
        pg8::gemm_phase<EpiMerge, true, pg8::NoTail, true>(lds, g, S, E);
    }
    if (chain_local) team_barrier(bar); else xcd_barrier(bar);

    {
        pg8::Gemm g{MERGED, Wo_t, M, 1024, 1024, nullptr, nullptr, 0}; pg8::StaticOrder S; S.init(M, 1024, G, cx, true);
        EpiX1 E{x, X1B, A2, ssq1, mod, ln_mlp_g};
        pg8::gemm_phase<EpiX1, true>(lds, g, S, E);
    }
    if (chain_local) team_barrier(bar); else xcd_barrier(bar);

    {
        pg8::Gemm g{A2, W1_t, M, DFF, 1024, nullptr, nullptr, 0}; pg8::StaticOrder S; S.init(M, DFF, G, cx, true);
        EpiFF1 E{U, ssq1, bias2};
        pg8::gemm_phase<EpiFF1, true, pg8::NoTail, false, 3>(lds, g, S, E);
    }
    if (chain_local) team_barrier(bar); else xcd_barrier(bar);

    const bool fuse_final = (M / 256) * (DM / 256) <= G;
    {
        pg8::Gemm g{U, W2_t, M, 1024, DFF, nullptr, nullptr, 0}; pg8::StaticOrder S; S.init(M, 1024, G, cx, true);
        EpiX2 E{X1B, out, ssq2, mod, fuse_final}; TailFinal T{out, ssq2, ln_final_g, bar, fuse_final, chain_local};
        pg8::gemm_phase<EpiX2, true, TailFinal, false, 3>(lds, g, S, E, T);
    }
    if (!fuse_final) {
        xcd_barrier(bar);
        PHASE_IDS;
        for (int mrow = gw; mrow < M; mrow += NGW) {
            const float rstd = __builtin_amdgcn_rsqf(ld_agent(ssq2 + mrow) * (1.f / 1024.f) + EPS);
            f32x4* xr = (f32x4*)(out + (size_t)mrow * 1024) + lane;
#pragma unroll
            for (int j = 0; j < 4; ++j) { const f32x4 g = *(const f32x4*)(ln_final_g + 4 * lane + 256 * j); xr[64 * j] = xr[64 * j] * rstd * g; }
        }
    }
}

extern "C" void kernel_launch(void* const* d_in, const int* in_sizes, int n_in, void* d_out, int out_size, void* d_ws, size_t ws_size, hipStream_t stream) {
    static int grid = 0;
    if (grid == 0) {
        if (n_in != 21 || in_sizes[0] != M * DM || out_size != M * DM || ws_size < WS_END) { fprintf(stderr, "kernel_launch: unexpected shapes (n_in %d, in0 %d, out %d, ws %zu); nothing launched\n", n_in, n_in > 0 ? in_sizes[0] : -1, out_size, ws_size); grid = -1; return; }
        int dev = 0, cus = 0, per_cu = 0;
        if (hipGetDevice(&dev) != hipSuccess || hipDeviceGetAttribute(&cus, hipDeviceAttributeMultiprocessorCount, dev) != hipSuccess) { grid = -1; return; }
        if (hipFuncSetAttribute((const void*)fwd_mega, hipFuncAttributeMaxDynamicSharedMemorySize, LDS_BYTES) != hipSuccess) { fprintf(stderr, "kernel_launch: hipFuncSetAttribute failed\n"); grid = -1; return; }
        if (hipOccupancyMaxActiveBlocksPerMultiprocessor(&per_cu, (const void*)fwd_mega, NWAVES * 64, LDS_BYTES) != hipSuccess || per_cu < 1) { fprintf(stderr, "kernel_launch: occupancy query says %d blocks per CU\n", per_cu); per_cu = 1; }
        (void)hipGetLastError();
        grid = cus;
        if (grid > 256) grid = 256;
    }
    if (grid < 0) return;
    Args a{};
    for (int i = 0; i < 21; ++i) a.in[i] = d_in[i];
    a.out = (float*)d_out; a.ws = (unsigned char*)d_ws;
    void* kargs[] = {&a};
    hipError_t e = hipLaunchCooperativeKernel((const void*)fwd_mega, dim3(grid), dim3(NWAVES * 64), kargs, LDS_BYTES, stream);
    if (e != hipSuccess) fprintf(stderr, "kernel_launch: cooperative launch failed: %s (grid %d)\n", hipGetErrorString(e), grid);
}
```

```cpp
#include <hip/hip_runtime.h>
#include <cstdio>
#include <cstdint>

#define GAS __attribute__((address_space(1)))
#define LAS __attribute__((address_space(3)))
typedef unsigned short bf16_t;
typedef short bf16x8 __attribute__((ext_vector_type(8)));
typedef short s16x4 __attribute__((ext_vector_type(4)));
typedef float f32x4 __attribute__((ext_vector_type(4)));
typedef float f32x16 __attribute__((ext_vector_type(16)));
typedef unsigned u32x4 __attribute__((ext_vector_type(4)));
typedef unsigned u32x2 __attribute__((ext_vector_type(2)));

constexpr int NB = 4, SEQ = 4096, DM = 1024, M = NB * SEQ, DFF = 4096;
constexpr int NIN = 3840;
constexpr float EPS = 1e-6f;
constexpr float LOG2E = 1.4426950408889634f;
constexpr float C2M = 0.10206207261596575f * LOG2E;
constexpr float C2S = 0.125f * LOG2E;

constexpr size_t MiB = 1u << 20;
constexpr size_t WS_CTL = 0, CTL_ZERO_BYTES = 1 * MiB;
constexpr size_t CTL_SSQ_Q = 256 * 1024, CTL_SSQ_KV = 320 * 1024, CTL_SSQ1 = 384 * 1024, CTL_SSQ2 = 640 * 1024;
constexpr size_t WS_WIN = 1 * MiB;
constexpr size_t WS_WUQ = WS_WIN + (size_t)NIN * 1024 * 2;
constexpr size_t WS_WUKV = WS_WUQ + 768 * 256 * 2;
constexpr size_t WS_WOMLA = WS_WUKV + 1024 * 128 * 2;
constexpr size_t WS_WOSWA = WS_WOMLA + 1024 * 512 * 2;
constexpr size_t WS_WO = WS_WOSWA + 1024 * 1024 * 2;
constexpr size_t WS_W1 = WS_WO + 1024 * 1024 * 2;
constexpr size_t WS_W2 = WS_W1 + (size_t)4096 * 1024 * 2;
constexpr size_t WS_MOD = WS_W2 + (size_t)4096 * 1024 * 2;
constexpr size_t WS_BIAS2 = WS_MOD + 4 * 6144 * 4;
constexpr size_t WS_TB = WS_BIAS2 + 4 * 4096 * 4;
constexpr size_t WS_SMALL_END = WS_TB + 16 * 132 * 4;
static_assert(WS_SMALL_END <= 32 * MiB, "small region");
constexpr size_t WS_QN = 32 * MiB, WS_QP = 48 * MiB, WS_KN = 56 * MiB, WS_VM = 72 * MiB, WS_CS = 88 * MiB, WS_SN = 89 * MiB;
constexpr size_t WS_X1B = 64 * MiB;
constexpr size_t WS_A2 = 32 * MiB;
constexpr size_t WS_QS = 96 * MiB, WS_GA = 128 * MiB, WS_GB = 160 * MiB, WS_QLAT = 192 * MiB, WS_KVLAT = 200 * MiB, WS_KPE = 204 * MiB, WS_KS = 205 * MiB, WS_VS = 209 * MiB;
constexpr size_t WS_U = 96 * MiB;
constexpr size_t WS_H = 224 * MiB, WS_MERGED = 224 * MiB;
constexpr size_t WS_END = 256 * MiB;
constexpr int CW_BAR = 4096, CW_FLAG = 64; constexpr unsigned CTL_READY = 0x5EED600Du;

constexpr int RING_BYTES = 131072, LDSCTL_OFF = RING_BYTES, MISC_OFF = LDSCTL_OFF + 320, LDS_BYTES = 147456;
constexpr int NWAVES = 8;

__device__ __forceinline__ unsigned f2bf(float f) { unsigned u = __builtin_bit_cast(unsigned, f); return (u + 0x7fffu + ((u >> 16) & 1u)) >> 16; }
__device__ __forceinline__ unsigned pk2(float lo, float hi) { return f2bf(lo) | (f2bf(hi) << 16); }
typedef float f32x2_t __attribute__((ext_vector_type(2))); typedef __bf16 bf16x2_t __attribute__((ext_vector_type(2)));
__device__ __forceinline__ unsigned cvt_pk_bf16(float lo, float hi) { f32x2_t v = {lo, hi}; bf16x2_t b = __builtin_convertvector(v, bf16x2_t); return __builtin_bit_cast(unsigned, b); }
__device__ __forceinline__ float bf2f(unsigned short b) { return __builtin_bit_cast(float, (unsigned)b << 16); }
__device__ __forceinline__ u32x2 pack4(f32x4 v) { u32x2 w; w.x = cvt_pk_bf16(v[0], v[1]); w.y = cvt_pk_bf16(v[2], v[3]); return w; }
__device__ __forceinline__ f32x4 unpack4(u32x2 w) { f32x4 v; v[0] = __builtin_bit_cast(float, w.x << 16); v[1] = __builtin_bit_cast(float, w.x & 0xffff0000u); v[2] = __builtin_bit_cast(float, w.y << 16); v[3] = __builtin_bit_cast(float, w.y & 0xffff0000u); return v; }

namespace pg8 {
constexpr int BM = 256, BK = 64, HALF = 128, HTB = HALF * BK * 2, STAGE_BYTES = 8 * HTB, NXCD = 8, WGM = 8;
__host__ __device__ __forceinline__ int lds_byte(int r, int c) { const int st = (r >> 4) * 2 + (c >> 5), rr = r & 15, cc = c & 31, ob = rr * 64 + cc * 2; return st * 1024 + (ob ^ (((ob >> 9) & 1) << 5)); }
__host__ __device__ __forceinline__ void stage_rc(int b, int& R, int& C) { const int st = b / 1024, sb = b % 1024, swz = sb ^ (((sb >> 9) & 1) << 5); R = (st >> 1) * 16 + swz / 64; C = (st & 1) * 32 + (swz % 64) / 2; }
__host__ __device__ __forceinline__ int perm32(int rho) { const int n = rho >> 4, i = rho & 15; return 8 * (i >> 2) + 4 * n + (i & 3); }
struct Unit { int pm, pn; };
__host__ __device__ __forceinline__ int pair_qb(int slot) { const int q = 4 * (slot >> 3) + ((slot & 7) >> 1); return (slot & 1) ? 15 - q : q; }
struct Gemm { const bf16_t* A; const bf16_t* Bt; int M, N, K; const bf16_t* A2; const bf16_t* Bt2; int K2; };
struct StaticOrder {
    int nM, nN, nwg, G, c; bool pp;
    __host__ __device__ void init(int M_, int N_, int G_, int c_, bool pp_ = false) { nM = M_ / BM; nN = N_ / BM; nwg = nM * nN; G = G_; c = c_; pp = pp_; }
    __host__ __device__ bool next(int i, Unit& u) const {
        const long L = (long)i * G + c; if (L >= nwg) return false;
        int wgid = (int)L; { const int q = nwg / NXCD, r = nwg % NXCD, xcd = wgid % NXCD, off = wgid / NXCD; wgid = (xcd < r ? xcd * (q + 1) : r * (q + 1) + (xcd - r) * q) + off; }
        const int nig = WGM * nN, gid = wgid / nig, fm = gid * WGM, gsz = (nM - fm) < WGM ? (nM - fm) : WGM;
        u.pm = fm + ((wgid % nig) % gsz); u.pn = (wgid % nig) / gsz;
        if (pp) u.pm = (u.pm & ~15) | pair_qb(u.pm & 15);
        return true;
    }
};
struct NoTail { template <class... A> __device__ __forceinline__ void operator()(A&&...) const {} };
template <class Epi, bool ALIGN_EPI, class Tail = NoTail, bool TWO = false, int TILED = 0>
__device__ __forceinline__ void gemm_phase(LAS unsigned char* lds, const Gemm g, const StaticOrder& S, const Epi& E, const Tail& T = Tail()) {
    int tid = threadIdx.x; asm volatile("" : "+v"(tid));
    const int wid = __builtin_amdgcn_readfirstlane(tid >> 6), lane = tid & 63, wr = wid >> 2, wc = wid & 3, fr = lane & 15, fq = lane >> 4;
    const int K = g.K, K2 = TWO ? g.K2 : 0, nt1 = K / BK, nt = nt1 + K2 / BK;
    unsigned voffA[2], voffB[2], voffA2[2], voffB2[2];
    constexpr bool TA = (TILED & 1) != 0, TB = (TILED & 2) != 0;
#pragma unroll
    for (int i = 0; i < 2; ++i) { int R, C; stage_rc(tid * 16 + i * 8192, R, C); const int Rb = (R & ~31) + perm32(R & 31);
        voffA[i] = (unsigned)(R * (TA ? BK : K) + C) * 2u; voffB[i] = (unsigned)(Rb * (TB ? BK : K) + C) * 2u;
        voffA2[i] = (unsigned)(R * (TA ? BK : K2) + C) * 2u; voffB2[i] = (unsigned)(Rb * (TB ? BK : K2) + C) * 2u; }
    const size_t kstepA = TA ? (size_t)BM * BK * 2 : (size_t)(BK * 2), kstepB = TB ? (size_t)BM * BK * 2 : (size_t)(BK * 2);
    const size_t hstepA = TA ? (size_t)HALF * BK * 2 : (size_t)HALF * K * 2, hstepA2 = TA ? (size_t)HALF * BK * 2 : (size_t)HALF * K2 * 2;
    const size_t hstepB = TB ? (size_t)HALF * BK * 2 : (size_t)HALF * K * 2, hstepB2 = TB ? (size_t)HALF * BK * 2 : (size_t)HALF * K2 * 2;
    const size_t tstepA = TA ? (size_t)nt1 * BM * BK * 2 : 2 * hstepA, tstepA2 = TA ? (size_t)(nt - nt1) * BM * BK * 2 : 2 * hstepA2;
    const size_t tstepB = TB ? (size_t)nt1 * BM * BK * 2 : 2 * hstepB, tstepB2 = TB ? (size_t)(nt - nt1) * BM * BK * 2 : 2 * hstepB2;
    const unsigned ldsw = (unsigned)wid * 1024u;
    const int aoff = lds_byte(wr * 64 + fr, fq * 8), boff = lds_byte(wc * 32 + fr, fq * 8);
#define PG8_SA(b, h) (((b) * 2 + (h)) * HTB)
#define PG8_SB(b, h) ((4 + (b) * 2 + (h)) * HTB)
#define PG8_STAGE(bufoff, gbase, voff) do { _Pragma("unroll") for (int _i = 0; _i < 2; ++_i) \
        __builtin_amdgcn_global_load_lds((const unsigned*)((const char*)(gbase) + (voff)[_i]), (LAS unsigned*)(lds + (bufoff) + ldsw + _i * 8192), 16, 0, 0); } while (0)
#define PG8_LDA(dst, b, h) do { _Pragma("unroll") for (int m = 0; m < 4; ++m) _Pragma("unroll") for (int k = 0; k < 2; ++k) dst[m][k] = *(const LAS bf16x8*)(lds + PG8_SA(b, h) + aoff + m * 2048 + k * 1024); } while (0)
#define PG8_LDB(dst, b, h) do { _Pragma("unroll") for (int n = 0; n < 2; ++n) _Pragma("unroll") for (int k = 0; k < 2; ++k) dst[n][k] = *(const LAS bf16x8*)(lds + PG8_SB(b, h) + boff + n * 2048 + k * 1024); } while (0)
#define PG8_MMA(ai, bj, At, Bt) do { __builtin_amdgcn_s_setprio(1); _Pragma("unroll") for (int m = 0; m < 4; ++m) _Pragma("unroll") for (int n = 0; n < 2; ++n) _Pragma("unroll") for (int k = 0; k < 2; ++k) \
        acc[ai][bj][m][n] = __builtin_amdgcn_mfma_f32_16x16x32_bf16(Bt[n][k], At[m][k], acc[ai][bj][m][n], 0, 0, 0); __builtin_amdgcn_s_setprio(0); } while (0)
#define PG8_WAIT_V(n) asm volatile("s_waitcnt vmcnt(" #n ")" ::: "memory")
#define PG8_WAIT_L(n) asm volatile("s_waitcnt lgkmcnt(" #n ")" ::: "memory")
#define PG8_BAR __builtin_amdgcn_s_barrier()
#define PG8_SCHED __builtin_amdgcn_sched_barrier(0)
    Unit cur, nxt; int ui = 0;
    if (!S.next(0, cur)) return;
    f32x4 acc[2][2][4][2];
#pragma unroll
    for (int a = 0; a < 2; ++a)
#pragma unroll
        for (int b = 0; b < 2; ++b)
#pragma unroll
            for (int m = 0; m < 4; ++m)
#pragma unroll
                for (int n = 0; n < 2; ++n) acc[a][b][m][n] = (f32x4){0.f, 0.f, 0.f, 0.f};
    bf16x8 At[4][2], B0[2][2], B1[2][2];
    const char* cA = (const char*)g.A + (size_t)cur.pm * tstepA; const char* cB = (const char*)g.Bt + (size_t)cur.pn * tstepB;
    const char* cA2 = TWO ? (const char*)g.A2 + (size_t)cur.pm * tstepA2 : nullptr; const char* cB2 = TWO ? (const char*)g.Bt2 + (size_t)cur.pn * tstepB2 : nullptr;
    PG8_STAGE(PG8_SB(0, 0), cB, voffB); PG8_STAGE(PG8_SB(0, 1), cB + hstepB, voffB); PG8_STAGE(PG8_SA(0, 0), cA, voffA); PG8_STAGE(PG8_SA(0, 1), cA + hstepA, voffA);
    if (wr == 1) PG8_BAR;
    PG8_WAIT_V(2); PG8_BAR;
    PG8_STAGE(PG8_SB(1, 0), cB + kstepB, voffB); PG8_STAGE(PG8_SA(1, 0), cA + kstepA, voffA); PG8_STAGE(PG8_SB(1, 1), cB + hstepB + kstepB, voffB);
    PG8_WAIT_V(6); PG8_BAR;
    for (;;) {
        const bool has_next = S.next(ui + 1, nxt);
        const char* nA = has_next ? (const char*)g.A + (size_t)nxt.pm * tstepA : cA; const char* nB = has_next ? (const char*)g.Bt + (size_t)nxt.pn * tstepB : cB;
        for (int t = 0; t < nt; t += 2) {
            const bool last = (t == nt - 2);
            if constexpr (TWO) { if (t == nt1) {
                if constexpr (ALIGN_EPI) { if (wr == 0) PG8_BAR; }
                E.mid(acc, cur, wr, wc, fr, fq);
                if constexpr (ALIGN_EPI) { if (wr == 1) PG8_BAR; } } }
            const bool s1 = !TWO || (t + 1 < nt1), s2 = !TWO || last || (t + 2 < nt1);
            const char* a1 = s1 ? cA + (size_t)(t + 1) * kstepA : cA2 + (size_t)(t + 1 - nt1) * kstepA; const size_t h1 = s1 ? hstepA : hstepA2; const unsigned vA1[2] = {s1 ? voffA[0] : voffA2[0], s1 ? voffA[1] : voffA2[1]};
            const char* a2 = last ? nA : (s2 ? cA + (size_t)(t + 2) * kstepA : cA2 + (size_t)(t + 2 - nt1) * kstepA);
            const char* b2 = last ? nB : (s2 ? cB + (size_t)(t + 2) * kstepB : cB2 + (size_t)(t + 2 - nt1) * kstepB);
            const size_t h2 = s2 ? hstepA : hstepA2, hb2 = s2 ? hstepB : hstepB2; const unsigned vA2[2] = {s2 ? voffA[0] : voffA2[0], s2 ? voffA[1] : voffA2[1]}, vB2[2] = {s2 ? voffB[0] : voffB2[0], s2 ? voffB[1] : voffB2[1]};
            const char* a3 = a2 + kstepA; const char* b3 = b2 + kstepB;
            PG8_LDB(B0, 0, 0); PG8_LDB(B1, 0, 1); PG8_SCHED; PG8_LDA(At, 0, 0); PG8_STAGE(PG8_SA(1, 1), a1 + h1, vA1);
            PG8_WAIT_V(8); PG8_WAIT_L(0); PG8_BAR; PG8_MMA(0, 0, At, B0); PG8_MMA(0, 1, At, B1); PG8_BAR; PG8_SCHED;
            PG8_LDA(At, 0, 1); PG8_STAGE(PG8_SB(0, 0), b2, vB2); PG8_STAGE(PG8_SB(0, 1), b2 + hb2, vB2); PG8_STAGE(PG8_SA(0, 0), a2, vA2);
            PG8_WAIT_V(8); PG8_WAIT_L(0); PG8_BAR; PG8_MMA(1, 0, At, B0); PG8_MMA(1, 1, At, B1); PG8_BAR; PG8_SCHED;
            PG8_LDB(B0, 1, 0); PG8_LDB(B1, 1, 1); PG8_SCHED; PG8_LDA(At, 1, 0); PG8_STAGE(PG8_SA(0, 1), a2 + h2, vA2);
            PG8_WAIT_V(8); PG8_WAIT_L(0); PG8_BAR; PG8_MMA(0, 0, At, B0); PG8_MMA(0, 1, At, B1); PG8_BAR; PG8_SCHED;
            PG8_LDA(At, 1, 1); PG8_STAGE(PG8_SB(1, 0), b3, vB2); PG8_STAGE(PG8_SB(1, 1), b3 + hb2, vB2); PG8_STAGE(PG8_SA(1, 0), a3, vA2);
            PG8_WAIT_V(8); PG8_WAIT_L(0); PG8_BAR; PG8_MMA(1, 0, At, B0); PG8_MMA(1, 1, At, B1); PG8_BAR; PG8_SCHED;
        }
        if constexpr (ALIGN_EPI) { if (wr == 0) PG8_BAR; }
        E(acc, cur, wr, wc, fr, fq);
        if (!has_next) break;
#pragma unroll
        for (int a = 0; a < 2; ++a)
#pragma unroll
            for (int b = 0; b < 2; ++b)
#pragma unroll
                for (int m = 0; m < 4; ++m)
#pragma unroll
                    for (int n = 0; n < 2; ++n) acc[a][b][m][n] = (f32x4){0.f, 0.f, 0.f, 0.f};
        cur = nxt; cA = nA; cB = nB; ++ui;
        if constexpr (TWO) { cA2 = (const char*)g.A2 + (size_t)cur.pm * tstepA2; cB2 = (const char*)g.Bt2 + (size_t)cur.pn * tstepB2; }
        if constexpr (ALIGN_EPI) { if (wr == 1) PG8_BAR; }
    }
    PG8_WAIT_V(0);
    if constexpr (!ALIGN_EPI) { if (wr == 0) PG8_BAR; }
    PG8_BAR;
    T(acc, cur, wr, wc, fr, fq);
#undef PG8_SA
#undef PG8_SB
#undef PG8_STAGE
#undef PG8_LDA
#undef PG8_LDB
#undef PG8_MMA
#undef PG8_WAIT_V
#undef PG8_WAIT_L
#undef PG8_BAR
#undef PG8_SCHED
}
}

#define EPI_ARGS f32x4 (&acc)[2][2][4][2], const pg8::Unit& u, int wr, int wc, int fr, int fq
#define FOR_AI_M _Pragma("unroll") for (int ai = 0; ai < 2; ++ai) _Pragma("unroll") for (int m = 0; m < 4; ++m)
#define FOR_BJ_N _Pragma("unroll") for (int bj = 0; bj < 2; ++bj) _Pragma("unroll") for (int n = 0; n < 2; ++n)
__device__ __forceinline__ float quad_sum(float s) { s += __shfl_xor(s, 16); s += __shfl_xor(s, 32); return s; }
__device__ __forceinline__ float ld_agent(const float* p) { return __hip_atomic_load(p, __ATOMIC_RELAXED, __HIP_MEMORY_SCOPE_AGENT); }
__device__ __forceinline__ float sigmoidf(float v) { return __builtin_amdgcn_rcpf(1.f + __expf(-v)); }

__device__ __forceinline__ u32x4 pack8(f32x4 a, f32x4 b) { u32x4 w; w.x = cvt_pk_bf16(a[0], a[1]); w.y = cvt_pk_bf16(a[2], a[3]); w.z = cvt_pk_bf16(b[0], b[1]); w.w = cvt_pk_bf16(b[2], b[3]); return w; }
__device__ __forceinline__ void unpack8(u32x4 w, f32x4& a, f32x4& b) { a = unpack4((u32x2){w.x, w.y}); b = unpack4((u32x2){w.z, w.w}); }
__device__ __forceinline__ float sumsq8(f32x4 a, f32x4 b) { return ((a[0] * a[0] + a[1] * a[1]) + (a[2] * a[2] + a[3] * a[3])) + ((b[0] * b[0] + b[1] * b[1]) + (b[2] * b[2] + b[3] * b[3])); }
#define FOR_BJ _Pragma("unroll") for (int bj = 0; bj < 2; ++bj)
constexpr int RED_OFF = LDSCTL_OFF + 4096;
__device__ __forceinline__ LAS float* red_base() { extern __shared__ __attribute__((aligned(16))) unsigned char lds_raw[]; return (LAS float*)((LAS unsigned char*)lds_raw + RED_OFF); }
__device__ __forceinline__ void red_put(float s, int wr, int wc, int ai, int m, int fr, int fq) { if (fq == 0) red_base()[wc * 256 + wr * 64 + ai * 128 + m * 16 + fr] = s; }
__device__ __forceinline__ void red_store(float* dst, int stride) {
    asm volatile("s_waitcnt lgkmcnt(0)" ::: "memory"); __builtin_amdgcn_s_barrier(); asm volatile("" ::: "memory");
    const int t = threadIdx.x;
    if (t < 256) { const LAS float* r = red_base() + t; dst[(size_t)t * stride] = (r[0] + r[256]) + (r[512] + r[768]); }
}

struct EpiP1 {
    bf16_t *QLAT, *KVLAT, *KPE, *QS, *KS, *VS, *GA, *GB; float *ssq_q, *ssq_kv; const float *cs, *sn, *bgate;
    __device__ __forceinline__ void operator()(EPI_ARGS) const {
        const int pn = u.pn, row0 = u.pm * 256 + wr * 64 + fr, cl = wc * 32 + fq * 8;
        if (pn == 0) {
            FOR_AI_M { const int row = row0 + ai * 128 + m * 16; float s = 0.f;
                FOR_BJ { s += sumsq8(acc[ai][bj][m][0], acc[ai][bj][m][1]); *(u32x4*)(QLAT + (size_t)row * 256 + bj * 128 + cl) = pack8(acc[ai][bj][m][0], acc[ai][bj][m][1]); }
                s = quad_sum(s); red_put(s, wr, wc, ai, m, fr, fq); }
            red_store(ssq_q + (size_t)u.pm * 256, 1);
        } else if (pn == 1) {
#pragma unroll
            for (int ai = 0; ai < 2; ++ai) {
                f32x4 c4[4], s4[4];
                if (wc == 0) {
#pragma unroll
                    for (int m = 0; m < 4; ++m) { const int row = row0 + ai * 128 + m * 16; c4[m] = *(const f32x4*)(cs + (size_t)row * 16 + fq * 4); s4[m] = *(const f32x4*)(sn + (size_t)row * 16 + fq * 4); } }
                asm volatile("" ::: "memory");
#pragma unroll
                for (int m = 0; m < 4; ++m) { const int row = row0 + ai * 128 + m * 16;
                    float s = sumsq8(acc[ai][0][m][0], acc[ai][0][m][1]); *(u32x4*)(KVLAT + (size_t)row * 128 + cl) = pack8(acc[ai][0][m][0], acc[ai][0][m][1]);
                    s = quad_sum(s); red_put(s, wr, wc, ai, m, fr, fq);
                    if (wc == 0) { const f32x4 t1 = acc[ai][1][m][0], t2 = acc[ai][1][m][1]; const f32x4 c = c4[m], sv = s4[m];
                        *(u32x4*)(KPE + (size_t)row * 32 + fq * 8) = pack8(t1 * c - t2 * sv, t1 * sv + t2 * c); } }
                asm volatile("" ::: "memory"); }
            red_store(ssq_kv + (size_t)u.pm * 256, 1);
        } else if (pn < 6) {
            const int cb = (pn - 2) * 256;
            FOR_AI_M { const int row = row0 + ai * 128 + m * 16;
                FOR_BJ *(u32x4*)(QS + (size_t)row * 1024 + cb + bj * 128 + cl) = pack8(acc[ai][bj][m][0] * C2S, acc[ai][bj][m][1] * C2S); }
        } else if (pn == 6) {
            FOR_AI_M { const int row = row0 + ai * 128 + m * 16;
                *(u32x4*)(KS + (size_t)row * 128 + cl) = pack8(acc[ai][0][m][0], acc[ai][0][m][1]); *(u32x4*)(VS + (size_t)row * 128 + cl) = pack8(acc[ai][1][m][0], acc[ai][1][m][1]); }
        } else {
            const int cb = (pn - 7) * 128 + cl; const float* bg = bgate + cb;
            f32x4 ba[2], bb[2];
#pragma unroll
            for (int n = 0; n < 2; ++n) { ba[n] = *(const f32x4*)(bg + n * 4); bb[n] = *(const f32x4*)(bg + 1024 + n * 4); }
            FOR_AI_M { const int row = row0 + ai * 128 + m * 16; f32x4 r[2], gb[2];
#pragma unroll
                for (int n = 0; n < 2; ++n) { const f32x4 va = acc[ai][0][m][n] + ba[n], vb = acc[ai][1][m][n] + bb[n];
#pragma unroll
                    for (int j = 0; j < 4; ++j) { const float eb1 = 1.f + fminf(__expf(-vb[j]), 1e30f); gb[n][j] = __builtin_amdgcn_rcpf(eb1); r[n][j] = eb1 * sigmoidf(va[j]); } }
                *(u32x4*)(GA + (size_t)row * 1024 + cb) = pack8(r[0], r[1]); *(u32x4*)(GB + (size_t)row * 1024 + cb) = pack8(gb[0], gb[1]); }
        }
    }
};
struct EpiQ {
    bf16_t *QN, *QP; const float *ssq_q, *cs, *sn;
    __device__ __forceinline__ void operator()(EPI_ARGS) const {
        const int pn = u.pn, row0 = u.pm * 256 + wr * 64 + fr, cl = wc * 32 + fq * 8;
        if (pn < 2) {
            FOR_AI_M { const int row = row0 + ai * 128 + m * 16; const float rs = __builtin_amdgcn_rsqf(ssq_q[row] * (1.f / 256.f) + EPS) * C2M;
                FOR_BJ *(u32x4*)(QN + (size_t)row * 512 + pn * 256 + bj * 128 + cl) = pack8(acc[ai][bj][m][0] * rs, acc[ai][bj][m][1] * rs); }
        } else {
#pragma unroll
            for (int g2 = 0; g2 < 4; ++g2) { f32x4 cc[2], ss[2]; float q2[2];
#pragma unroll
                for (int h = 0; h < 2; ++h) { const int g = 2 * g2 + h; const int row = row0 + (g >> 2) * 128 + (g & 3) * 16; const float* p0 = ssq_q + row; const float* p1 = cs + (size_t)row * 16 + fq * 4; const float* p2 = sn + (size_t)row * 16 + fq * 4;
                    asm volatile("global_load_dword %0, %1, off" : "=v"(q2[h]) : "v"(p0) : "memory"); asm volatile("global_load_dwordx4 %0, %1, off" : "=v"(cc[h]) : "v"(p1) : "memory"); asm volatile("global_load_dwordx4 %0, %1, off" : "=v"(ss[h]) : "v"(p2) : "memory"); }
                asm volatile("s_waitcnt vmcnt(0)" : "+v"(q2[0]), "+v"(q2[1]), "+v"(cc[0]), "+v"(cc[1]), "+v"(ss[0]), "+v"(ss[1]) :: "memory");
#pragma unroll
                for (int h = 0; h < 2; ++h) { const int g = 2 * g2 + h, ai = g >> 2, m = g & 3; const int row = row0 + ai * 128 + m * 16; const float rs = __builtin_amdgcn_rsqf(q2[h] * (1.f / 256.f) + EPS) * C2M;
                    const f32x4 c = cc[h] * rs, sv = ss[h] * rs;
                    FOR_BJ { const f32x4 t1 = acc[ai][bj][m][0], t2 = acc[ai][bj][m][1];
                        *(u32x4*)(QP + (size_t)row * 256 + (bj * 4 + wc) * 32 + fq * 8) = pack8(t1 * c - t2 * sv, t1 * sv + t2 * c); } } }
        }
    }
};
struct EpiKV {
    bf16_t *KN, *VM; const float* ssq_kv;
    __device__ __forceinline__ void operator()(EPI_ARGS) const {
        const int pn = u.pn, row0 = u.pm * 256 + wr * 64 + fr, cl = wc * 32 + fq * 8; bf16_t* O = (pn < 2 ? KN : VM) + (pn & 1) * 256;
        FOR_AI_M { const int row = row0 + ai * 128 + m * 16; const float rs = __builtin_amdgcn_rsqf(ssq_kv[row] * (1.f / 128.f) + EPS);
            FOR_BJ *(u32x4*)(O + (size_t)row * 512 + bj * 128 + cl) = pack8(acc[ai][bj][m][0] * rs, acc[ai][bj][m][1] * rs); }
    }
};
struct EpiMerge {
    const bf16_t *GA, *GB; bf16_t* T;
    __device__ __forceinline__ void mid(EPI_ARGS) const {
        int row0 = u.pm * 256 + wr * 64 + fr; const int c0 = u.pn * 256 + wc * 32 + fq * 8;
        asm volatile("" : "+v"(row0));
#pragma unroll
        for (int ai = 0; ai < 2; ++ai) { u32x4 g[4][2];
#pragma unroll
            for (int m = 0; m < 4; ++m) FOR_BJ { const bf16_t* p = GA + (size_t)(row0 + ai * 128 + m * 16) * 1024 + c0 + bj * 128; asm volatile("global_load_dwordx4 %0, %1, off" : "=v"(g[m][bj]) : "v"(p) : "memory"); }
            asm volatile("s_waitcnt vmcnt(0)" : "+v"(g[0][0]), "+v"(g[0][1]), "+v"(g[1][0]), "+v"(g[1][1]), "+v"(g[2][0]), "+v"(g[2][1]), "+v"(g[3][0]), "+v"(g[3][1]) :: "memory");
#pragma unroll
            for (int m = 0; m < 4; ++m) FOR_BJ { f32x4 r0, r1; unpack8(g[m][bj], r0, r1); acc[ai][bj][m][0] *= r0; acc[ai][bj][m][1] *= r1; } }
    }
    __device__ __forceinline__ void operator()(EPI_ARGS) const {
        const int row0 = u.pm * 256 + wr * 64 + fr, c0 = u.pn * 256 + wc * 32 + fq * 8;
        FOR_AI_M { const int row = row0 + ai * 128 + m * 16;
            FOR_BJ { const size_t off = (size_t)row * 1024 + c0 + bj * 128; f32x4 g0, g1; unpack8(*(const u32x4*)(GB + off), g0, g1);
                *(u32x4*)(T + off) = pack8(g0 * acc[ai][bj][m][0], g1 * acc[ai][bj][m][1]); } }
    }
};
struct EpiX1 {
    const float* x; bf16_t* X1B; bf16_t* A2; float* ssq1; const float* mod; const float* gmlp;
    __device__ __forceinline__ void operator()(EPI_ARGS) const {
        const int row0 = u.pm * 256 + wr * 64 + fr, c0 = u.pn * 256 + wc * 32 + fq * 8; const float* mb = mod + (size_t)(u.pm >> 4) * 6144;
        f32x4 ga[2][2], gm[2][2];
        FOR_BJ_N { const int c = c0 + bj * 128 + n * 4; ga[bj][n] = *(const f32x4*)(mb + 2 * 1024 + c); gm[bj][n] = (*(const f32x4*)(mb + 4 * 1024 + c) + 1.f) * *(const f32x4*)(gmlp + c); }
        f32x4 xv[2][2][2];
#define X1_LOAD(slot, g) { const int row_ = row0 + ((g) >> 2) * 128 + ((g) & 3) * 16; FOR_BJ_N xv[slot][bj][n] = __builtin_nontemporal_load((const f32x4*)(x + (size_t)row_ * 1024 + c0 + bj * 128 + n * 4)); }
        X1_LOAD(0, 0)
#pragma unroll
        for (int g = 0; g < 8; ++g) { const int ai = g >> 2, m = g & 3; const int row = row0 + ai * 128 + m * 16; float s = 0.f;
            if (g < 7) X1_LOAD((g + 1) & 1, g + 1)
            asm volatile("" ::: "memory");
            FOR_BJ { const size_t off = (size_t)row * 1024 + c0 + bj * 128;
                const f32x4 v0 = xv[g & 1][bj][0] + ga[bj][0] * acc[ai][bj][m][0], v1 = xv[g & 1][bj][1] + ga[bj][1] * acc[ai][bj][m][1];
                s += sumsq8(v0, v1); *(u32x4*)(X1B + off) = pack8(v0, v1); *(u32x4*)(A2 + off) = pack8(v0 * gm[bj][0], v1 * gm[bj][1]); }
            s = quad_sum(s); red_put(s, wr, wc, ai, m, fr, fq); }
#undef X1_LOAD
        red_store(ssq1 + (size_t)u.pm * 256 * 4 + u.pn, 4);
    }
};
struct EpiFF1 {
    bf16_t* U; const float* ssq1; const float* bias2;
    __device__ __forceinline__ void operator()(EPI_ARGS) const {
        const int row0 = u.pm * 256 + wr * 64 + fr, c0 = u.pn * 256 + wc * 32 + fq * 8; const float* bb = bias2 + (size_t)(u.pm >> 4) * 4096;
        f32x4 bv[2][2];
        FOR_BJ_N bv[bj][n] = *(const f32x4*)(bb + c0 + bj * 128 + n * 4);
        f32x4 pq[2][4];
        FOR_AI_M pq[ai][m] = *(const f32x4*)(ssq1 + (size_t)(row0 + ai * 128 + m * 16) * 4);
        asm volatile("" ::: "memory");
        FOR_AI_M { const int row = row0 + ai * 128 + m * 16; const f32x4 p4 = pq[ai][m]; const float rs = __builtin_amdgcn_rsqf(((p4[0] + p4[1]) + (p4[2] + p4[3])) * (1.f / 1024.f) + EPS);
            FOR_BJ { f32x4 v0 = acc[ai][bj][m][0] * rs + bv[bj][0], v1 = acc[ai][bj][m][1] * rs + bv[bj][1];
                v0[0] = fmaxf(v0[0], 0.f); v0[1] = fmaxf(v0[1], 0.f); v0[2] = fmaxf(v0[2], 0.f); v0[3] = fmaxf(v0[3], 0.f); v1[0] = fmaxf(v1[0], 0.f); v1[1] = fmaxf(v1[1], 0.f); v1[2] = fmaxf(v1[2], 0.f); v1[3] = fmaxf(v1[3], 0.f);
                *(u32x4*)(U + ((size_t)(u.pm * 64 + u.pn * 4 + bj * 2 + (wc >> 1)) * 256 + (row & 255)) * 64 + (wc & 1) * 32 + fq * 8) = pack8(v0 * v0, v1 * v1); } }
    }
};
struct EpiX2 {
    const bf16_t* X1B; float* X; float* ssq2; const float* mod; bool fuse;
    __device__ __forceinline__ void operator()(EPI_ARGS) const {
        const int row0 = u.pm * 256 + wr * 64 + fr, c0 = u.pn * 256 + wc * 32 + fq * 8; const float* mb = mod + (size_t)(u.pm >> 4) * 6144;
        f32x4 ga[2][2];
        FOR_BJ_N ga[bj][n] = *(const f32x4*)(mb + 5 * 1024 + c0 + bj * 128 + n * 4);
        if (fuse) {
#pragma unroll
            for (int ai = 0; ai < 2; ++ai) { u32x4 xb[4][2];
#pragma unroll
                for (int m = 0; m < 4; ++m) FOR_BJ xb[m][bj] = *(const u32x4*)(X1B + (size_t)(row0 + ai * 128 + m * 16) * 1024 + c0 + bj * 128);
#pragma unroll
                for (int m = 0; m < 4; ++m) { float s = 0.f;
                    FOR_BJ { f32x4 x0, x1v; unpack8(xb[m][bj], x0, x1v);
                        const f32x4 v0 = x0 + ga[bj][0] * acc[ai][bj][m][0], v1 = x1v + ga[bj][1] * acc[ai][bj][m][1];
                        s += sumsq8(v0, v1); acc[ai][bj][m][0] = v0; acc[ai][bj][m][1] = v1; }
                    s = quad_sum(s); red_put(s, wr, wc, ai, m, fr, fq); } }
        } else {
        FOR_AI_M { const int row = row0 + ai * 128 + m * 16; float s = 0.f;
            FOR_BJ { const size_t off = (size_t)row * 1024 + c0 + bj * 128; f32x4 x0, x1v; unpack8(*(const u32x4*)(X1B + off), x0, x1v);
                const f32x4 v0 = x0 + ga[bj][0] * acc[ai][bj][m][0], v1 = x1v + ga[bj][1] * acc[ai][bj][m][1];
                s += sumsq8(v0, v1); *(f32x4*)(X + off) = v0; *(f32x4*)(X + off + 4) = v1; }
            s = quad_sum(s); red_put(s, wr, wc, ai, m, fr, fq); }
        }
        red_store(ssq2 + (size_t)u.pm * 256 * 4 + u.pn, 4);
    }
};
namespace att {
constexpr int VB = 8192;
constexpr float THR = 8.f;
__device__ __forceinline__ void glds16(const void* g, LAS unsigned char* l) { unsigned keep; const unsigned dst = (unsigned)__builtin_amdgcn_readfirstlane((int)(unsigned)(uintptr_t)l);
    asm volatile("s_mov_b32 %0, m0\n\ts_mov_b32 m0, %2\n\ts_nop 0\n\tglobal_load_lds_dwordx4 %1, off\n\ts_mov_b32 m0, %0" : "=&s"(keep) : "v"(g), "s"(dst) : "memory"); }
__device__ __forceinline__ s16x4 vtr(const LAS unsigned char* p) { return __builtin_bit_cast(s16x4, __builtin_amdgcn_ds_read_tr16_b64_v4i16((LAS s16x4*)p)); }
__device__ __forceinline__ float max3(float a, float b, float c) { return fmaxf(fmaxf(a, b), c); }
#define ATT_WAITBAR_N(n) do { if ((n) == 0) ATT_WAITBAR(0); else if ((n) == 1) ATT_WAITBAR(1); else if ((n) == 2) ATT_WAITBAR(2); else ATT_WAITBAR(3); } while (0)
#define ATT_WAITBAR(N) do { asm volatile("s_waitcnt vmcnt(" #N ") lgkmcnt(0)" ::: "memory"); __builtin_amdgcn_s_barrier(); asm volatile("" ::: "memory"); } while (0)
struct State { float m; f32x16 negm, lacc, o[2]; };
#define SBAR() __builtin_amdgcn_sched_barrier(0)
#define K_RD(i) asm volatile("ds_read_b128 %0, %1 offset:%c2" : "=v"(kf[i]) : "v"(kaddr), "i"(((i) >> 1) * 2048 + ((i) & 1) * 512) : "memory")
#define V_RD(i) asm volatile("ds_read_b64_tr_b16 %0, %1 offset:%c2" : "=v"(vf[i]) : "v"(vaddr), "i"(((((i) >> 1) & 3) * 1024) + (((i) & 1) * 512)) : "memory")
template <int NKS> __device__ __forceinline__ void k_issue(bf16x8* kf, unsigned kaddr) {
    K_RD(0); K_RD(1); K_RD(2); K_RD(3); K_RD(4); K_RD(5); K_RD(6); K_RD(7);
    if constexpr (NKS == 6) { K_RD(8); K_RD(9); K_RD(10); K_RD(11); }
}
template <int NKS> __device__ __forceinline__ void k_fence(bf16x8* kf) {
    if constexpr (NKS == 6) asm volatile("" : "+v"(kf[0]), "+v"(kf[1]), "+v"(kf[2]), "+v"(kf[3]), "+v"(kf[4]), "+v"(kf[5]), "+v"(kf[6]), "+v"(kf[7]), "+v"(kf[8]), "+v"(kf[9]), "+v"(kf[10]), "+v"(kf[11]));
    else asm volatile("" : "+v"(kf[0]), "+v"(kf[1]), "+v"(kf[2]), "+v"(kf[3]), "+v"(kf[4]), "+v"(kf[5]), "+v"(kf[6]), "+v"(kf[7]));
}
__device__ __forceinline__ void v_issue(s16x4* vf, unsigned vaddr) {
    V_RD(0); V_RD(1); V_RD(2); V_RD(3); V_RD(4); V_RD(5); V_RD(6); V_RD(7);
}
__device__ __forceinline__ void v_wait(s16x4* vf) {
    asm volatile("s_waitcnt lgkmcnt(0)" : "+v"(vf[0]), "+v"(vf[1]), "+v"(vf[2]), "+v"(vf[3]), "+v"(vf[4]), "+v"(vf[5]), "+v"(vf[6]), "+v"(vf[7]));
}
__device__ __forceinline__ void v_wait8(s16x4* vf) {
    asm volatile("s_waitcnt lgkmcnt(8)" : "+v"(vf[0]), "+v"(vf[1]), "+v"(vf[2]), "+v"(vf[3]), "+v"(vf[4]), "+v"(vf[5]), "+v"(vf[6]), "+v"(vf[7]));
}
__device__ __forceinline__ void k_wait8_4(bf16x8* kf) {
    asm volatile("s_waitcnt lgkmcnt(8)" : "+v"(kf[0]), "+v"(kf[1]), "+v"(kf[2]), "+v"(kf[3]), "+v"(kf[4]), "+v"(kf[5]), "+v"(kf[6]), "+v"(kf[7]));
}
template <int NKS> __device__ __forceinline__ void k_wait(bf16x8* kf) {
    if constexpr (NKS == 6) asm volatile("s_waitcnt lgkmcnt(0)" : "+v"(kf[0]), "+v"(kf[1]), "+v"(kf[2]), "+v"(kf[3]), "+v"(kf[4]), "+v"(kf[5]), "+v"(kf[6]), "+v"(kf[7]), "+v"(kf[8]), "+v"(kf[9]), "+v"(kf[10]), "+v"(kf[11]));
    else asm volatile("s_waitcnt lgkmcnt(0)" : "+v"(kf[0]), "+v"(kf[1]), "+v"(kf[2]), "+v"(kf[3]), "+v"(kf[4]), "+v"(kf[5]), "+v"(kf[6]), "+v"(kf[7]));
}
template <int NKS> __device__ __forceinline__ void qk_mma(f32x16& p0, f32x16& p1, const bf16x8* kf, const bf16x8* qr, const f32x16& negm) {
#pragma unroll
    for (int ks = 0; ks < NKS; ++ks) {
        if (ks == 0) { p0 = __builtin_amdgcn_mfma_f32_32x32x16_bf16(kf[0], qr[0], negm, 0, 0, 0); p1 = __builtin_amdgcn_mfma_f32_32x32x16_bf16(kf[1], qr[0], negm, 0, 0, 0); }
        else { p0 = __builtin_amdgcn_mfma_f32_32x32x16_bf16(kf[2 * ks], qr[ks], p0, 0, 0, 0); p1 = __builtin_amdgcn_mfma_f32_32x32x16_bf16(kf[2 * ks + 1], qr[ks], p1, 0, 0, 0); }
    }
}
__device__ __forceinline__ void decide(f32x16& c0, f32x16& c1, bool first, State& st) {
    float a = max3(c0[0], c0[1], c1[0]), b = max3(c0[2], c0[3], c1[1]); a = max3(a, c1[2], c1[3]);
#pragma unroll
    for (int r = 4; r < 16; r += 4) { a = max3(a, c0[r], c0[r + 1]); b = max3(b, c0[r + 2], c0[r + 3]); a = max3(a, c1[r], c1[r + 1]); b = max3(b, c1[r + 2], c1[r + 3]); }
    float mx = fmaxf(a, b);
    { auto rr = __builtin_amdgcn_permlane32_swap(__float_as_uint(mx), __float_as_uint(mx), false, false); mx = fmaxf(__uint_as_float(rr[0]), __uint_as_float(rr[1])); }
    if (first || __any(mx > THR)) {
        const float dl = first ? mx : fmaxf(mx, 0.f), f = __builtin_amdgcn_exp2f(-dl);
        st.m += dl;
#pragma unroll
        for (int r = 0; r < 16; ++r) { c0[r] -= dl; c1[r] -= dl; st.negm[r] = -st.m; st.o[0][r] *= f; st.o[1][r] *= f; st.lacc[r] *= f; }
    }
}
__device__ __forceinline__ void exp_pack(f32x16& p0, f32x16& p1, bf16x8* pa) {
#pragma unroll
    for (int r = 0; r < 16; ++r) { p0[r] = __builtin_amdgcn_exp2f(p0[r]); p1[r] = __builtin_amdgcn_exp2f(p1[r]); }
    u32x4 w0 = {cvt_pk_bf16(p0[0], p0[1]), cvt_pk_bf16(p0[2], p0[3]), cvt_pk_bf16(p0[4], p0[5]), cvt_pk_bf16(p0[6], p0[7])};
    u32x4 w1 = {cvt_pk_bf16(p0[8], p0[9]), cvt_pk_bf16(p0[10], p0[11]), cvt_pk_bf16(p0[12], p0[13]), cvt_pk_bf16(p0[14], p0[15])};
    u32x4 w2 = {cvt_pk_bf16(p1[0], p1[1]), cvt_pk_bf16(p1[2], p1[3]), cvt_pk_bf16(p1[4], p1[5]), cvt_pk_bf16(p1[6], p1[7])};
    u32x4 w3 = {cvt_pk_bf16(p1[8], p1[9]), cvt_pk_bf16(p1[10], p1[11]), cvt_pk_bf16(p1[12], p1[13]), cvt_pk_bf16(p1[14], p1[15])};
    pa[0] = __builtin_bit_cast(bf16x8, w0); pa[1] = __builtin_bit_cast(bf16x8, w1); pa[2] = __builtin_bit_cast(bf16x8, w2); pa[3] = __builtin_bit_cast(bf16x8, w3);
}
template <bool LSUM> __device__ __forceinline__ void pv_mma(f32x16& o, f32x16& lacc, const s16x4* vf, const bf16x8* pa) {
    const u32x4 onew = {0x3f803f80u, 0x3f803f80u, 0x3f803f80u, 0x3f803f80u}; const bf16x8 ones = __builtin_bit_cast(bf16x8, onew);
#pragma unroll
    for (int ks = 0; ks < 4; ++ks) {
        if (LSUM) lacc = __builtin_amdgcn_mfma_f32_32x32x16_bf16(ones, pa[ks], lacc, 0, 0, 0);
        const s16x4 lo = vf[ks * 2], hh = vf[ks * 2 + 1];
        const bf16x8 v = {lo[0], lo[1], lo[2], lo[3], hh[0], hh[1], hh[2], hh[3]};
        o = __builtin_amdgcn_mfma_f32_32x32x16_bf16(v, pa[ks], o, 0, 0, 0);
    }
}
__device__ __forceinline__ void store_o(bf16_t* orow, const f32x16* o, float inv, int hi) {
#pragma unroll
    for (int d0 = 0; d0 < 2; ++d0)
#pragma unroll
        for (int g = 0; g < 4; ++g) { f32x4 v = {o[d0][4 * g], o[d0][4 * g + 1], o[d0][4 * g + 2], o[d0][4 * g + 3]}; *(u32x2*)(orow + d0 * 32 + 8 * g + 4 * hi) = pack4(v * inv); }
}

constexpr int MLA_KB = 12288, MLA_NK = 4, MLA_NV = 4, MLA_V0 = MLA_NK * MLA_KB, MLA_LDS = MLA_V0 + MLA_NV * VB;
__device__ __forceinline__ void mla_mask(f32x16& p0, f32x16& p1, int t, int qrow, int hi) {
    int d = qrow - 64 * t - 4 * hi; asm volatile("" : "+v"(d));
#pragma unroll
    for (int r = 0; r < 16; ++r) { const int cr = (r & 3) + 8 * (r >> 2); p0[r] = (cr <= d) ? p0[r] : -INFINITY; p1[r] = (cr + 32 <= d) ? p1[r] : -INFINITY; }
}
struct St2 { float m, l; f32x16 o[2], negm; };
__device__ __forceinline__ bf16x8 ldv2(const LAS unsigned char* p) { const s16x4 lo = vtr(p), hh = vtr(p + 512); return (bf16x8){lo[0], lo[1], lo[2], lo[3], hh[0], hh[1], hh[2], hh[3]}; }
template <bool DO_PV, bool DO_QK>
__device__ __forceinline__ float mla_iter(f32x16& s0, f32x16& s1, f32x16& n0, f32x16& n1, const bf16x8* pin, bf16x8* pout, St2& st, const bf16x8* qr,
                                          const LAS unsigned char* kslot, const LAS unsigned char* vslot, bool MASK, bool first, bool grpB, int nis, int t, int qrow, int r32, int hi, int lane) {
    const LAS unsigned char* vp = vslot + ((lane >> 4) & 1) * 32 + (lane & 3) * 8 + (4 * hi + ((lane & 15) >> 2)) * 64;
    const LAS unsigned char* kb = kslot + hi * 1024 + r32 * 16;
    if (MASK) mla_mask(s0, s1, t, qrow, hi);
#define LDV(ks, d0) (DO_PV ? ldv2(vp + (d0) * 4096 + (ks) * 1024) : (bf16x8){0, 0, 0, 0, 0, 0, 0, 0})
#define LDK(ks, hf) (DO_QK ? *(const LAS bf16x8*)(kb + (ks) * 2048 + (hf) * 512) : (bf16x8){0, 0, 0, 0, 0, 0, 0, 0})
    const bf16x8 fr0 = LDV(0, 0);
    const bf16x8 fr1 = LDV(0, 1);
    const bf16x8 fr2 = LDV(1, 0);
    const bf16x8 fr3 = LDV(1, 1);
    if (DO_PV) st.o[0] = __builtin_amdgcn_mfma_f32_32x32x16_bf16(fr0, pin[0], st.o[0], 0, 0, 0);
    float a = max3(s0[0], s0[1], s1[0]), b = max3(s0[2], s0[3], s1[1]);
    a = max3(a, s1[2], s1[3]);
    a = max3(a, s0[4], s0[5]); b = max3(b, s0[6], s0[7]);
    a = max3(a, s1[4], s1[5]); b = max3(b, s1[6], s1[7]);
    asm volatile("" : "+v"(a), "+v"(b));
    SBAR();
    const bf16x8 fr4 = LDV(2, 0);
    if (DO_PV) st.o[1] = __builtin_amdgcn_mfma_f32_32x32x16_bf16(fr1, pin[0], st.o[1], 0, 0, 0);
    a = max3(a, s0[8], s0[9]); b = max3(b, s0[10], s0[11]);
    a = max3(a, s1[8], s1[9]); b = max3(b, s1[10], s1[11]);
    a = max3(a, s0[12], s0[13]); b = max3(b, s0[14], s0[15]);
    a = max3(a, s1[12], s1[13]); b = max3(b, s1[14], s1[15]);
    asm volatile("" : "+v"(a), "+v"(b));
    SBAR();
    const bf16x8 fr5 = LDV(2, 1);
    if (DO_PV) st.o[0] = __builtin_amdgcn_mfma_f32_32x32x16_bf16(fr2, pin[1], st.o[0], 0, 0, 0);
    float mx = fmaxf(a, b);
    { auto rr = __builtin_amdgcn_permlane32_swap(__float_as_uint(mx), __float_as_uint(mx), false, false); mx = fmaxf(__uint_as_float(rr[0]), __uint_as_float(rr[1])); }
    asm volatile("" : "+v"(mx));
    SBAR();
    const bf16x8 fr6 = LDV(3, 0);
    if (DO_PV) st.o[1] = __builtin_amdgcn_mfma_f32_32x32x16_bf16(fr3, pin[1], st.o[1], 0, 0, 0);
    float f = 1.f;
    if (first || __any(mx > THR)) {
        const float dl = (first || mx > THR) ? mx : 0.f; f = __builtin_amdgcn_exp2f(-dl); st.m += dl;
        _Pragma("unroll") for (int r = 0; r < 16; ++r) { s0[r] -= dl; s1[r] -= dl; st.negm[r] = -st.m; }
    }
    float sum = 0.f;
    unsigned pk0, pk1, pk2, pk3, pk4, pk5, pk6, pk7, pk8, pk9, pk10, pk11, pk12, pk13, pk14, pk15;
    SBAR();
    const bf16x8 fr7 = LDV(3, 1);
    if (DO_PV) st.o[0] = __builtin_amdgcn_mfma_f32_32x32x16_bf16(fr4, pin[2], st.o[0], 0, 0, 0);
    s0[0] = __builtin_amdgcn_exp2f(s0[0]);
    s0[1] = __builtin_amdgcn_exp2f(s0[1]);
    asm volatile("" : "+v"(sum), "+v"(s0[0]), "+v"(s0[1]));
    SBAR();
    const bf16x8 fr8 = LDK(0, 0);
    if (DO_PV) st.o[1] = __builtin_amdgcn_mfma_f32_32x32x16_bf16(fr5, pin[2], st.o[1], 0, 0, 0);
    s0[2] = __builtin_amdgcn_exp2f(s0[2]);
    s0[3] = __builtin_amdgcn_exp2f(s0[3]);
    sum += s0[0]; sum += s0[1];
    pk0 = cvt_pk_bf16(s0[0], s0[1]);
    asm volatile("" : "+v"(sum), "+v"(s0[2]), "+v"(s0[3]), "+v"(pk0));
    SBAR();
    const bf16x8 fr9 = LDK(0, 1);
    if (DO_PV) st.o[0] = __builtin_amdgcn_mfma_f32_32x32x16_bf16(fr6, pin[3], st.o[0], 0, 0, 0);
    s0[4] = __builtin_amdgcn_exp2f(s0[4]);
    s0[5] = __builtin_amdgcn_exp2f(s0[5]);
    sum += s0[2]; sum += s0[3];
    pk1 = cvt_pk_bf16(s0[2], s0[3]);
    asm volatile("" : "+v"(sum), "+v"(s0[4]), "+v"(s0[5]), "+v"(pk1));
    SBAR();
    const bf16x8 fr10 = LDK(1, 0);
    if (DO_PV) st.o[1] = __builtin_amdgcn_mfma_f32_32x32x16_bf16(fr7, pin[3], st.o[1], 0, 0, 0);
    s0[6] = __builtin_amdgcn_exp2f(s0[6]);
    s0[7] = __builtin_amdgcn_exp2f(s0[7]);
    sum += s0[4]; sum += s0[5];
    pk2 = cvt_pk_bf16(s0[4], s0[5]);
    asm volatile("" : "+v"(sum), "+v"(s0[6]), "+v"(s0[7]), "+v"(pk2));
    SBAR();
    if (grpB) ATT_WAITBAR_N(nis);
    const bf16x8 fr11 = LDK(1, 1);
    if (DO_QK) n0 = __builtin_amdgcn_mfma_f32_32x32x16_bf16(fr8, qr[0], st.negm, 0, 0, 0);
    s0[8] = __builtin_amdgcn_exp2f(s0[8]);
    s0[9] = __builtin_amdgcn_exp2f(s0[9]);
    sum += s0[6]; sum += s0[7];
    pk3 = cvt_pk_bf16(s0[6], s0[7]);
    asm volatile("" : "+v"(sum), "+v"(s0[8]), "+v"(s0[9]), "+v"(pk3));
    SBAR();
    const bf16x8 fr12 = LDK(2, 0);
    if (DO_QK) n1 = __builtin_amdgcn_mfma_f32_32x32x16_bf16(fr9, qr[0], st.negm, 0, 0, 0);
    s0[10] = __builtin_amdgcn_exp2f(s0[10]);
    s0[11] = __builtin_amdgcn_exp2f(s0[11]);
    sum += s0[8]; sum += s0[9];
    pk4 = cvt_pk_bf16(s0[8], s0[9]);
    asm volatile("" : "+v"(sum), "+v"(s0[10]), "+v"(s0[11]), "+v"(pk4));
    SBAR();
    const bf16x8 fr13 = LDK(2, 1);
    if (DO_QK) n0 = __builtin_amdgcn_mfma_f32_32x32x16_bf16(fr10, qr[1], n0, 0, 0, 0);
    s0[12] = __builtin_amdgcn_exp2f(s0[12]);
    s0[13] = __builtin_amdgcn_exp2f(s0[13]);
    sum += s0[10]; sum += s0[11];
    pk5 = cvt_pk_bf16(s0[10], s0[11]);
    asm volatile("" : "+v"(sum), "+v"(s0[12]), "+v"(s0[13]), "+v"(pk5));
    SBAR();
    const bf16x8 fr14 = LDK(3, 0);
    if (DO_QK) n1 = __builtin_amdgcn_mfma_f32_32x32x16_bf16(fr11, qr[1], n1, 0, 0, 0);
    s0[14] = __builtin_amdgcn_exp2f(s0[14]);
    s0[15] = __builtin_amdgcn_exp2f(s0[15]);
    sum += s0[12]; sum += s0[13];
    pk6 = cvt_pk_bf16(s0[12], s0[13]);
    asm volatile("" : "+v"(sum), "+v"(s0[14]), "+v"(s0[15]), "+v"(pk6));
    SBAR();
    const bf16x8 fr15 = LDK(3, 1);
    if (DO_QK) n0 = __builtin_amdgcn_mfma_f32_32x32x16_bf16(fr12, qr[2], n0, 0, 0, 0);
    s1[0] = __builtin_amdgcn_exp2f(s1[0]);
    s1[1] = __builtin_amdgcn_exp2f(s1[1]);
    sum += s0[14]; sum += s0[15];
    pk7 = cvt_pk_bf16(s0[14], s0[15]);
    asm volatile("" : "+v"(sum), "+v"(s1[0]), "+v"(s1[1]), "+v"(pk7));
    SBAR();
    const bf16x8 fr16 = LDK(4, 0);
    if (DO_QK) n1 = __builtin_amdgcn_mfma_f32_32x32x16_bf16(fr13, qr[2], n1, 0, 0, 0);
    s1[2] = __builtin_amdgcn_exp2f(s1[2]);
    s1[3] = __builtin_amdgcn_exp2f(s1[3]);
    sum += s1[0]; sum += s1[1];
    pk8 = cvt_pk_bf16(s1[0], s1[1]);
    asm volatile("" : "+v"(sum), "+v"(s1[2]), "+v"(s1[3]), "+v"(pk8));
    SBAR();
    const bf16x8 fr17 = LDK(4, 1);
    if (DO_QK) n0 = __builtin_amdgcn_mfma_f32_32x32x16_bf16(fr14, qr[3], n0, 0, 0, 0);
    s1[4] = __builtin_amdgcn_exp2f(s1[4]);
    s1[5] = __builtin_amdgcn_exp2f(s1[5]);
    sum += s1[2]; sum += s1[3];
    pk9 = cvt_pk_bf16(s1[2], s1[3]);
    asm volatile("" : "+v"(sum), "+v"(s1[4]), "+v"(s1[5]), "+v"(pk9));
    SBAR();
    const bf16x8 fr18 = LDK(5, 0);
    if (DO_QK) n1 = __builtin_amdgcn_mfma_f32_32x32x16_bf16(fr15, qr[3], n1, 0, 0, 0);
    s1[6] = __builtin_amdgcn_exp2f(s1[6]);
    s1[7] = __builtin_amdgcn_exp2f(s1[7]);
    sum += s1[4]; sum += s1[5];
    pk10 = cvt_pk_bf16(s1[4], s1[5]);
    asm volatile("" : "+v"(sum), "+v"(s1[6]), "+v"(s1[7]), "+v"(pk10));
    SBAR();
    const bf16x8 fr19 = LDK(5, 1);
    if (DO_QK) n0 = __builtin_amdgcn_mfma_f32_32x32x16_bf16(fr16, qr[4], n0, 0, 0, 0);
    s1[8] = __builtin_amdgcn_exp2f(s1[8]);
    s1[9] = __builtin_amdgcn_exp2f(s1[9]);
    sum += s1[6]; sum += s1[7];
    pk11 = cvt_pk_bf16(s1[6], s1[7]);
    asm volatile("" : "+v"(sum), "+v"(s1[8]), "+v"(s1[9]), "+v"(pk11));
    SBAR();
    if (DO_QK) n1 = __builtin_amdgcn_mfma_f32_32x32x16_bf16(fr17, qr[4], n1, 0, 0, 0);
    s1[10] = __builtin_amdgcn_exp2f(s1[10]);
    s1[11] = __builtin_amdgcn_exp2f(s1[11]);
    sum += s1[8]; sum += s1[9];
    pk12 = cvt_pk_bf16(s1[8], s1[9]);
    asm volatile("" : "+v"(sum), "+v"(s1[10]), "+v"(s1[11]), "+v"(pk12));
    SBAR();
    if (DO_QK) n0 = __builtin_amdgcn_mfma_f32_32x32x16_bf16(fr18, qr[5], n0, 0, 0, 0);
    s1[12] = __builtin_amdgcn_exp2f(s1[12]);
    s1[13] = __builtin_amdgcn_exp2f(s1[13]);
    sum += s1[10]; sum += s1[11];
    pk13 = cvt_pk_bf16(s1[10], s1[11]);
    asm volatile("" : "+v"(sum), "+v"(s1[12]), "+v"(s1[13]), "+v"(pk13));
    SBAR();
    if (DO_QK) n1 = __builtin_amdgcn_mfma_f32_32x32x16_bf16(fr19, qr[5], n1, 0, 0, 0);
    s1[14] = __builtin_amdgcn_exp2f(s1[14]);
    s1[15] = __builtin_amdgcn_exp2f(s1[15]);
    sum += s1[12]; sum += s1[13];
    pk14 = cvt_pk_bf16(s1[12], s1[13]);
    asm volatile("" : "+v"(sum), "+v"(s1[14]), "+v"(s1[15]), "+v"(pk14));
    SBAR();
    sum += s1[14]; sum += s1[15]; pk15 = cvt_pk_bf16(s1[14], s1[15]);
    st.l = st.l * f + sum;
    pout[0] = __builtin_bit_cast(bf16x8, (u32x4){pk0, pk1, pk2, pk3}); pout[1] = __builtin_bit_cast(bf16x8, (u32x4){pk4, pk5, pk6, pk7}); pout[2] = __builtin_bit_cast(bf16x8, (u32x4){pk8, pk9, pk10, pk11}); pout[3] = __builtin_bit_cast(bf16x8, (u32x4){pk12, pk13, pk14, pk15});
#undef LDV
#undef LDK
    return f;
}
__device__ __forceinline__ void mla_unit2(int b, int h, int qb, const bf16_t* QN, const bf16_t* QP, const bf16_t* KN, const bf16_t* KPE, const bf16_t* VM, bf16_t* O, LAS unsigned char* shm) {
    int tid = threadIdx.x; asm volatile("" : "+v"(tid));
    const int lane = tid & 63, r32 = lane & 31, hi = lane >> 5, wid = __builtin_amdgcn_readfirstlane(tid >> 6);
    const size_t rb = (size_t)b * SEQ; const int q0 = qb * 256, qrow = q0 + wid * 32 + r32, NT = (q0 + 256) / 64;
    const bf16_t* ksrc = KN + (rb + lane) * 512 + h * 64 + wid * 8;
    const bf16_t* psrc = KPE + (rb + lane) * 32 + (wid & 3) * 8;
    const bf16_t* vsrc = VM + (rb + 16 * (wid & 3) + (lane >> 2)) * 512 + h * 64 + (wid >> 2) * 32 + (lane & 3) * 8;
    constexpr int npk = 2;
#define MLA_DMA_K(t, s) do { LAS unsigned char* sl_ = shm + (s) * MLA_KB; glds16(ksrc + (size_t)(t) * 64 * 512, sl_ + wid * 1024); glds16(psrc + (size_t)(t) * 64 * 32, sl_ + (8 + (wid & 3)) * 1024); } while (0)
#define MLA_DMA_V(t, s) glds16(vsrc + (size_t)(t) * 64 * 512, shm + MLA_V0 + (s) * VB + wid * 1024)
    MLA_DMA_K(0, 0); MLA_DMA_K(1, 1);
    bf16x8 qr[6];
#pragma unroll
    for (int ks = 0; ks < 4; ++ks) qr[ks] = *(const bf16x8*)(QN + (rb + qrow) * 512 + h * 64 + ks * 16 + hi * 8);
#pragma unroll
    for (int ks = 0; ks < 2; ++ks) qr[4 + ks] = *(const bf16x8*)(QP + (rb + qrow) * 256 + h * 32 + ks * 16 + hi * 8);
    MLA_DMA_K(2, 2); MLA_DMA_V(0, 0);
    St2 st; st.m = 0.f; st.l = 0.f; st.o[0] = f32x16{}; st.o[1] = f32x16{}; st.negm = f32x16{};
    ATT_WAITBAR_N(npk + 1);
    f32x16 sa0, sa1, sb0, sb1; bf16x8 pb[4];
    { const LAS unsigned char* kb = shm + hi * 1024 + r32 * 16;
#pragma unroll
      for (int ks = 0; ks < 6; ++ks) { const bf16x8 k0 = *(const LAS bf16x8*)(kb + ks * 2048), k1 = *(const LAS bf16x8*)(kb + ks * 2048 + 512);
          if (ks == 0) { sa0 = __builtin_amdgcn_mfma_f32_32x32x16_bf16(k0, qr[0], f32x16{}, 0, 0, 0); sa1 = __builtin_amdgcn_mfma_f32_32x32x16_bf16(k1, qr[0], f32x16{}, 0, 0, 0); }
          else { sa0 = __builtin_amdgcn_mfma_f32_32x32x16_bf16(k0, qr[ks], sa0, 0, 0, 0); sa1 = __builtin_amdgcn_mfma_f32_32x32x16_bf16(k1, qr[ks], sa1, 0, 0, 0); } } }
    float fprev = 1.f; const bool grpB = wid >= 4;
#define MLA_ITER(PV, QK, I, SC0, SC1, SN0, SN1) do { const int i_ = (I); int nis = 0; \
        if (i_ + 3 < NT) { MLA_DMA_K(i_ + 3, (i_ + 3) & 3); nis += npk; } \
        if (i_ + 1 < NT) { MLA_DMA_V(i_ + 1, (i_ + 1) & 3); nis += 1; } \
        if (__any(fprev != 1.f)) { _Pragma("unroll") for (int r = 0; r < 16; ++r) { st.o[0][r] *= fprev; st.o[1][r] *= fprev; } } \
        fprev = mla_iter<PV, QK>(SC0, SC1, SN0, SN1, pb, pb, st, qr, shm + ((i_ + 1) & 3) * MLA_KB, shm + MLA_V0 + ((i_ - 1) & 3) * VB, (i_ >= NT - 4) && ((wid >> 1) <= i_ - (NT - 4)), i_ == 0, grpB, nis, i_, qrow, r32, hi, lane);     \
        if (!grpB) ATT_WAITBAR_N(nis); } while (0)
#define MLA_STEADY(I, SC0, SC1, SN0, SN1) do { const int i_ = (I); \
        MLA_DMA_K(i_ + 3, (i_ + 3) & 3); MLA_DMA_V(i_ + 1, (i_ + 1) & 3); \
        if (__any(fprev != 1.f)) { _Pragma("unroll") for (int r = 0; r < 16; ++r) { st.o[0][r] *= fprev; st.o[1][r] *= fprev; } } \
        fprev = mla_iter<true, true>(SC0, SC1, SN0, SN1, pb, pb, st, qr, shm + ((i_ + 1) & 3) * MLA_KB, shm + MLA_V0 + ((i_ - 1) & 3) * VB, false, false, grpB, 3, i_, qrow, r32, hi, lane); \
        if (!grpB) ATT_WAITBAR(3); } while (0)
    MLA_ITER(false, true, 0, sa0, sa1, sb0, sb1);
    int i = 1;
    for (; i + 1 < NT - 4; i += 2) {
        MLA_STEADY(i, sb0, sb1, sa0, sa1);
        MLA_STEADY(i + 1, sa0, sa1, sb0, sb1);
    }
    for (; i < NT - 1; i += 2) {
        MLA_ITER(true, true, i, sb0, sb1, sa0, sa1);
        MLA_ITER(true, true, i + 1, sa0, sa1, sb0, sb1);
    }
    MLA_ITER(true, false, NT - 1, sb0, sb1, sa0, sa1);
#undef MLA_STEADY
#undef MLA_ITER
    if (__any(fprev != 1.f)) {
#pragma unroll
        for (int r = 0; r < 16; ++r) { st.o[0][r] *= fprev; st.o[1][r] *= fprev; } }
    { const LAS unsigned char* vp = shm + MLA_V0 + ((NT - 1) & 3) * VB + ((lane >> 4) & 1) * 32 + (lane & 3) * 8 + (4 * hi + ((lane & 15) >> 2)) * 64;
#pragma unroll
      for (int ks = 0; ks < 4; ++ks)
#pragma unroll
          for (int d0 = 0; d0 < 2; ++d0) { const s16x4 lo = vtr(vp + d0 * 4096 + ks * 1024), hh = vtr(vp + d0 * 4096 + ks * 1024 + 512);
              const bf16x8 v = {lo[0], lo[1], lo[2], lo[3], hh[0], hh[1], hh[2], hh[3]};
              st.o[d0] = __builtin_amdgcn_mfma_f32_32x32x16_bf16(v, pb[ks], st.o[d0], 0, 0, 0); } }
#undef MLA_DMA_K
#undef MLA_DMA_V
    float l = st.l; { auto rr = __builtin_amdgcn_permlane32_swap(__float_as_uint(l), __float_as_uint(l), false, false); l = __uint_as_float(rr[0]) + __uint_as_float(rr[1]); }
    store_o(O + (rb + qrow) * 512 + h * 64, st.o, __builtin_amdgcn_rcpf(l), hi);
    ATT_WAITBAR(0);
}
constexpr int SWA_KB = 8192, SWA_V0 = 4 * SWA_KB;
constexpr int SWA_TB_OFF = MLA_LDS, SWA_PK_OFF = SWA_TB_OFF + 16 * 132 * 4, SWA_FLG_OFF = SWA_PK_OFF + 1024, SWA_TBX_OFF = SWA_FLG_OFF + 64;
static_assert(SWA_TBX_OFF + 16 * 384 * 4 <= RING_BYTES, "attention LDS map");
static_assert(SWA_V0 + 4 * VB <= SWA_TB_OFF, "SWA band below the bias table");
__device__ __forceinline__ void swa_mask_bias(f32x16& p0, f32x16& p1, int t, int a, int pq, const LAS int* pk, const LAS float* tb, int hi) {
    const int kb = 64 * t + 4 * hi;
#pragma unroll
    for (int r = 0; r < 16; ++r) {
        const int bk0 = kb + (r & 3) + 8 * (r >> 2), bk1 = bk0 + 32;
        const int d0 = min(max(pq - pk[bk0], 0), 128), d1 = min(max(pq - pk[bk1], 0), 128);
        p0[r] = (bk0 > a && bk0 <= a + 128) ? p0[r] + tb[d0] : -INFINITY;
        p1[r] = (bk1 > a && bk1 <= a + 128) ? p1[r] + tb[d1] : -INFINITY; }
}
__device__ __forceinline__ void swa_mask_bias_contig(f32x16& p0, f32x16& p1, int t, int a, const LAS float* tbx, int hi) {
    const int db = 128 + a - 64 * t - 4 * hi; const LAS float* tp = tbx + (128 + db - 59);
#pragma unroll
    for (int r = 0; r < 16; ++r) { const int cr = (r & 3) + 8 * (r >> 2); p0[r] += tp[59 - cr]; p1[r] += tp[27 - cr]; }
}
__device__ __forceinline__ void swa_unit(int b, int n, int kvh, const bf16_t* QS, const bf16_t* KS, const bf16_t* VS, bf16_t* O, const int* pos, const float* sinks, LAS unsigned char* shm) {
    int tid = threadIdx.x; asm volatile("" : "+v"(tid));
    const int lane = tid & 63, r32 = lane & 31, hi = lane >> 5, wid = __builtin_amdgcn_readfirstlane(tid >> 6);
    const size_t rb = (size_t)b * SEQ; const int a0 = (wid & 3) * 32, a = a0 + r32, qrow = n * 128 + a;
    const int kt0 = n == 0 ? 2 : 0; const long band0 = (long)rb + n * 128 - 128;
    const bf16_t* ksrc = KS + (band0 + lane) * 128 + kvh * 64 + wid * 8;
    const bf16_t* vsrc = VS + (band0 + 16 * (wid & 3) + (lane >> 2)) * 128 + kvh * 64 + (wid >> 2) * 32 + (lane & 3) * 8;
    for (int t = kt0; t < 4; ++t) { glds16(ksrc + (long)t * 64 * 128, shm + t * SWA_KB + wid * 1024); glds16(vsrc + (long)t * 64 * 128, shm + SWA_V0 + t * VB + wid * 1024); }
    LAS int* pk = (LAS int*)(shm + SWA_PK_OFF); LAS int* flg = (LAS int*)(shm + SWA_FLG_OFF);
    if (tid < 256) { const long r = band0 + tid; const bool valid = r >= (long)rb; const int p = valid ? pos[r] : 0; pk[tid] = p;
        const bool ok = !valid || (p - tid == pos[rb + n * 128] - 128); const bool all = __all(ok); if (lane == 0) flg[wid] = all ? 1 : 0; }
    const int pq = pos[rb + qrow];
    const int tlo = a0 >= 64 ? (kt0 > 1 ? kt0 : 1) : kt0, thi = a0 >= 64 ? 3 : 2;
    const bf16_t* qsrc = QS + (rb + qrow) * 1024 + (kvh * 8 + (wid >> 2)) * 64 + hi * 8;
    bf16x8 qn[4];
#pragma unroll
    for (int ks = 0; ks < 4; ++ks) qn[ks] = *(const bf16x8*)(qsrc + ks * 16);
    ATT_WAITBAR(0);
    const bool contig = __builtin_amdgcn_readfirstlane(flg[0] & flg[1] & flg[2] & flg[3]) != 0;
    const unsigned lds0 = (unsigned)(uintptr_t)shm, klane = lds0 + hi * 1024 + r32 * 16, vlane = lds0 + SWA_V0 + ((lane >> 4) & 1) * 32 + (lane & 3) * 8 + (4 * hi + ((lane & 15) >> 2)) * 64;
    for (int hp = 0; hp < 4; ++hp) {
        const int head = kvh * 8 + 2 * hp + (wid >> 2);
        bf16x8 qr[4];
#pragma unroll
        for (int ks = 0; ks < 4; ++ks) qr[ks] = qn[ks];
        if (hp < 3) {
#pragma unroll
            for (int ks = 0; ks < 4; ++ks) qn[ks] = *(const bf16x8*)(qsrc + (hp + 1) * 128 + ks * 16);
        }
        const LAS float* tb = (const LAS float*)(shm + SWA_TB_OFF) + head * 132; const LAS float* tbx = (const LAS float*)(shm + SWA_TBX_OFF) + head * 384;
        State st; st.m = sinks[head] * LOG2E; st.o[0] = f32x16{}; st.o[1] = f32x16{};
#pragma unroll
        for (int r = 0; r < 16; ++r) { st.negm[r] = -st.m; st.lacc[r] = 1.f; }
        bf16x8 kf[8]; k_issue<4>(kf, klane + tlo * SWA_KB);
        for (int t = tlo; t <= thi; ++t) {
            s16x4 vf[8], vg[8]; bf16x8 pa[4]; f32x16 c0, c1;
            v_issue(vf, vlane + t * VB);
            SBAR();
            k_wait8_4(kf);
            SBAR();
            v_issue(vg, vlane + t * VB + 4096);
            SBAR();
            qk_mma<4>(c0, c1, kf, qr, st.negm);
            if (contig) swa_mask_bias_contig(c0, c1, t, a, tbx, hi); else swa_mask_bias(c0, c1, t, a, pq, pk, tb, hi);
            decide(c0, c1, false, st);
            exp_pack(c0, c1, pa);
            SBAR();
            if (t < thi) k_issue<4>(kf, klane + (t + 1) * SWA_KB);
            SBAR();
            if (t < thi) { v_wait8(vf); v_wait8(vg); } else { v_wait(vf); v_wait(vg); }
            SBAR();
            pv_mma<true>(st.o[0], st.lacc, vf, pa);
            pv_mma<false>(st.o[1], st.lacc, vg, pa);
        }
        store_o(O + (rb + qrow) * 1024 + head * 64, st.o, __builtin_amdgcn_rcpf(st.lacc[0]), hi);
    }
    ATT_WAITBAR(0);
}
}

#define XB_TMO      128
#define XB_XCNT(j)  (256  + 64 * (j))
#define XB_XSUB(j)  (1280 + 64 * (j))
#define XB_XGEN(j)  (2304 + 64 * (j))
#define XB_TOP      3328
#define XB_TOPGEN   3392
#define XCD_BAR_WORDS 3456
#define XB_SPIN_CAP (1u << 18)
__device__ __forceinline__ unsigned xb_ld(unsigned* p)              { return __hip_atomic_load(p, __ATOMIC_RELAXED, __HIP_MEMORY_SCOPE_AGENT); }
__device__ __forceinline__ unsigned xb_add(unsigned* p, unsigned v) { return __hip_atomic_fetch_add(p, v, __ATOMIC_RELAXED, __HIP_MEMORY_SCOPE_AGENT); }
__device__ __forceinline__ unsigned xb_xcc_id() { return (unsigned)__builtin_amdgcn_s_getreg((3 << 11) | 20) & 0xFu; }
#define XB_SPIN(cond, bar) do { unsigned _sp = 0; while (cond) { __builtin_amdgcn_s_sleep(1); \
    if ((++_sp & 255u) == 0u) { if (xb_ld(&(bar)[XB_TMO])) break; if (_sp > XB_SPIN_CAP) { atomicAdd(&(bar)[XB_TMO], 1u); break; } } } } while (0)
#define XB_EARLY_INV() asm volatile("buffer_inv sc1" ::: "memory")
struct XcdBarrier { unsigned* bar; unsigned x; volatile LAS unsigned* st; };
__device__ __forceinline__ XcdBarrier xcd_barrier_post(unsigned* bar, volatile LAS unsigned* st) {
    XcdBarrier b; b.bar = bar; b.x = xb_xcc_id(); b.st = st;
    if (threadIdx.x == 0) st[2] = xb_add(&bar[XB_XCNT(b.x)], 1u);
    return b;
}
__device__ __forceinline__ void xcd_barrier_complete(unsigned* bar, unsigned x, unsigned& nloc, unsigned& nx) {
    const unsigned G = gridDim.x * gridDim.y * gridDim.z;
    unsigned sum, cnt, mine, sp = 0u;
    for (;;) {
        sum = 0u; cnt = 0u; mine = 0u;
#pragma unroll
        for (unsigned j = 0; j < 16; ++j) { const unsigned c = xb_ld(&bar[XB_XCNT(j)]); sum += c; cnt += (c > 0u) ? 1u : 0u; mine = (j == x) ? c : mine; }
        if (sum == G) break;
        __builtin_amdgcn_s_sleep(1);
        if ((++sp & 255u) == 0u) { if (xb_ld(&bar[XB_TMO])) break; if (sp > XB_SPIN_CAP) { atomicAdd(&bar[XB_TMO], 1u); break; } }
    }
    nloc = mine > 0u ? mine : 1u; nx = cnt > 0u ? cnt : 1u;
}
__device__ __forceinline__ void xcd_barrier(const XcdBarrier& b) {
    asm volatile("s_waitcnt vmcnt(0)" ::: "memory");
    __syncthreads();
    if (threadIdx.x == 0) {
        unsigned* bar = b.bar;
        __builtin_amdgcn_s_waitcnt(0);
        unsigned nloc = b.st[0], nx = b.st[1];
        if (nloc == 0u) { xcd_barrier_complete(bar, b.x, nloc, nx); b.st[0] = nloc; b.st[1] = nx; }
        const unsigned old = xb_add(&bar[XB_XSUB(b.x)], 1u);
        const unsigned gen = old / nloc;
        if (old + 1u == (gen + 1u) * nloc) {
            __builtin_amdgcn_fence(__ATOMIC_RELEASE, "agent");
            asm volatile("s_waitcnt vmcnt(0)" ::: "memory");
            const unsigned og = xb_add(&bar[XB_TOP], 1u);
            const unsigned tg = og / nx;
            if (og + 1u == (tg + 1u) * nx) xb_add(&bar[XB_TOPGEN], 1u);
            else XB_SPIN(xb_ld(&bar[XB_TOPGEN]) == tg, bar);
            __builtin_amdgcn_fence(__ATOMIC_ACQUIRE, "agent");
            xb_add(&bar[XB_XGEN(b.x)], 1u);
            asm volatile("s_waitcnt vmcnt(0)" ::: "memory");
        } else {
            XB_EARLY_INV();
            XB_SPIN(xb_ld(&bar[XB_XGEN(b.x)]) == gen, bar);
            asm volatile("s_waitcnt vmcnt(0)" ::: "memory");
        }
    }
    __syncthreads();
}

#define XT_CNT(t)  (XCD_BAR_WORDS + 2048 + 64 * (t))
#define XT_GEN(t)  (XCD_BAR_WORDS + 2048 + 4096 + 64 * (t))
__device__ __forceinline__ void team_barrier(const XcdBarrier& b) {
    asm volatile("s_waitcnt vmcnt(0)" ::: "memory");
    __syncthreads();
    if (threadIdx.x == 0) {
        unsigned* bar = b.bar; const unsigned c = b.st[4], team = ((c & 7u) << 3) | ((c >> 3) & 7u);
        const unsigned old = xb_add(&bar[XT_CNT(team)], 1u);
        XB_EARLY_INV();
        const unsigned gen = old >> 2;
        if ((old & 3u) == 3u) xb_add(&bar[XT_GEN(team)], 1u);
        else XB_SPIN(xb_ld(&bar[XT_GEN(team)]) == gen, bar);
        asm volatile("s_waitcnt vmcnt(0)" ::: "memory");
    }
    __syncthreads();
}
#define XD_CNT(t)  (XCD_BAR_WORDS + 2048 + 8192 + 64 * (t))
#define XD_GEN(t)  (XCD_BAR_WORDS + 2048 + 8192 + 2048 + 64 * (t))
__device__ __forceinline__ void pair_barrier(const XcdBarrier& b) {
    asm volatile("s_waitcnt vmcnt(0)" ::: "memory");
    __syncthreads();
    if (threadIdx.x == 0) {
        unsigned* bar = b.bar; const unsigned c = b.st[4], dt = ((c & 7u) << 2) | ((c >> 4) & 3u);
        const unsigned old = xb_add(&bar[XD_CNT(dt)], 1u);
        XB_EARLY_INV();
        const unsigned gen = old >> 3;
        if ((old & 7u) == 7u) xb_add(&bar[XD_GEN(dt)], 1u);
        else XB_SPIN(xb_ld(&bar[XD_GEN(dt)]) == gen, bar);
        asm volatile("s_waitcnt vmcnt(0)" ::: "memory");
    }
    __syncthreads();
}
__device__ __forceinline__ void chain_setup(const XcdBarrier& b) {
    if (threadIdx.x == 0) {
        const unsigned G = gridDim.x; unsigned slot = 0, nx = 0; bool uni = (G % 8u) == 0u;
#pragma unroll
        for (unsigned j = 0; j < 16; ++j) { const unsigned c = xb_ld(&b.bar[XB_XCNT(j)]); if (c) { ++nx; if (c != G / 8u) uni = false; if (j < b.x) ++slot; } }
        const bool ok = uni && nx == 8u && G == 256u && b.st[2] < G / 8u;
        b.st[3] = ok ? 1u : 0u; b.st[4] = ok ? b.st[2] * 8u + slot : blockIdx.x;
    }
    __syncthreads();
}
struct TailFinal {
    float* out; const float* ssq2; const float* gfin; XcdBarrier bar; bool fuse, local;
    __device__ __forceinline__ void operator()(EPI_ARGS) const {
        if (!fuse) return;
        const int row0 = u.pm * 256 + wr * 64 + fr, c0 = u.pn * 256 + wc * 32 + fq * 8;
        f32x4 gf[2][2];
        FOR_BJ_N gf[bj][n] = *(const f32x4*)(gfin + c0 + bj * 128 + n * 4);
        if (local) team_barrier(bar); else xcd_barrier(bar);
        FOR_AI_M { const int row = row0 + ai * 128 + m * 16; const f32x4 p4 = *(const f32x4*)(ssq2 + (size_t)row * 4); const float rs = __builtin_amdgcn_rsqf(((p4[0] + p4[1]) + (p4[2] + p4[3])) * (1.f / 1024.f) + EPS);
            FOR_BJ_N __builtin_nontemporal_store(acc[ai][bj][m][n] * rs * gf[bj][n], (f32x4*)(out + (size_t)row * 1024 + c0 + bj * 128 + n * 4)); }
    }
};
__device__ __forceinline__ float wave_sum(float v) {
#pragma unroll
    for (int o = 1; o < 64; o <<= 1) v += __shfl_xor(v, o);
    return v;
}
__device__ __forceinline__ int ropepos(int d) { return 8 * ((d >> 2) & 3) + 4 * (d >> 4) + (d & 3); }
template <int MAP> __device__ __forceinline__ int wmap(int n) {
    if (MAP == 1) { if (n >= 384 && n < 416) return 384 + ropepos(n - 384); if (n < 416) return n; if (n < 1696) return n + 96;
        const int g = n - 1696, c = g & 1023; return 1792 + (c >> 7) * 256 + (g >> 10) * 128 + (c & 127); }
    if (MAP == 2) { const int h = n / 96, d = n - h * 96; return d < 64 ? h * 64 + d : 512 + h * 32 + ropepos(d - 64); }
    if (MAP == 3) { const int h = n >> 7, d = n & 127; return d < 64 ? h * 64 + d : 512 + h * 64 + (d - 64); }
    return n;
}
__device__ __forceinline__ void transpose_load(const float* W, int N, int item, int lane, float (&wv)[32]) {
    const int nblk = N / 32, kb = item / nblk, nb = item % nblk, k0 = 64 * kb, n0 = 32 * nb;
#pragma unroll
    for (int i = 0; i < 32; ++i) wv[i] = __builtin_nontemporal_load(W + (size_t)(k0 + 2 * i + (lane >> 5)) * N + n0 + (lane & 31));
}
template <int MAP, bool TILED = false> __device__ __forceinline__ void transpose_finish(const float (&wv)[32], int K, int N, bf16_t* WT, const float* rs, LAS float* scr, int item, int lane) {
    const int nblk = N / 32, kb = item / nblk, nb = item % nblk, k0 = 64 * kb, n0 = 32 * nb;
    const int c = lane & 7;
    f32x4 r0 = {1.f, 1.f, 1.f, 1.f}, r1 = r0;
    if (rs) { r0 = *(const f32x4*)(rs + k0 + 8 * c); r1 = *(const f32x4*)(rs + k0 + 8 * c + 4); }
#pragma unroll
    for (int i = 0; i < 32; ++i) { const int kk = 2 * i + (lane >> 5); scr[kk * 33 + (lane & 31)] = wv[i]; }
    asm volatile("s_waitcnt lgkmcnt(0)" ::: "memory");
#pragma unroll
    for (int j = 0; j < 4; ++j) { const int n = (lane >> 3) + 8 * j; const LAS float* s = scr + (8 * c) * 33 + n;
        u32x4 o;
        if (rs) { o.x = pk2(s[0 * 33] * r0[0], s[1 * 33] * r0[1]); o.y = pk2(s[2 * 33] * r0[2], s[3 * 33] * r0[3]); o.z = pk2(s[4 * 33] * r1[0], s[5 * 33] * r1[1]); o.w = pk2(s[6 * 33] * r1[2], s[7 * 33] * r1[3]); }
        else { o.x = pk2(s[0 * 33], s[1 * 33]); o.y = pk2(s[2 * 33], s[3 * 33]); o.z = pk2(s[4 * 33], s[5 * 33]); o.w = pk2(s[6 * 33], s[7 * 33]); }
        const int nn = wmap<MAP>(n0 + n);
        if (TILED) *(u32x4*)(WT + ((size_t)((nn >> 8) * (K >> 6) + kb) * 256 + (nn & 255)) * 64 + 8 * c) = o;
        else *(u32x4*)(WT + (size_t)nn * K + k0 + 8 * c) = o; }
    asm volatile("s_waitcnt lgkmcnt(0)" ::: "memory");
}
template <int MAP, bool TILED = false> __device__ __forceinline__ void transpose_item(const float* W, int K, int N, bf16_t* WT, const float* rs, LAS float* scr, int item, int lane) {
    float wv[32]; transpose_load(W, N, item, lane, wv); transpose_finish<MAP, TILED>(wv, K, N, WT, rs, scr, item, lane);
}
__device__ const float ROPE_INV[16] = {1.0f, 0.5623413251903491f, 0.31622776601683794f, 0.1778279410038923f, 0.1f, 0.05623413251903491f, 0.03162277660168379f, 0.01778279410038923f,
    0.01f, 0.005623413251903491f, 0.0031622776601683794f, 0.0017782794100389228f, 0.001f, 0.0005623413251903491f, 0.00031622776601683794f, 0.00017782794100389227f};

struct Args { const void* in[21]; float* out; unsigned char* ws; };
__device__ __forceinline__ int otid() { int t = threadIdx.x; asm volatile("" : "+v"(t)); return t; }
#define PHASE_IDS const int tid = otid(), lane = tid & 63, wave = __builtin_amdgcn_readfirstlane(tid >> 6), gw = vcu * NWAVES + wave; (void)lane; (void)gw

__global__ void __launch_bounds__(NWAVES * 64, 2) fwd_mega(Args args) {
    extern __shared__ __attribute__((aligned(16))) unsigned char lds_raw[];
    LAS unsigned char* lds = (LAS unsigned char*)lds_raw;
    volatile LAS unsigned* MISC = (volatile LAS unsigned*)(lds + MISC_OFF);
    const int G = gridDim.x, bx = blockIdx.x, vcu = (G % 8 == 0) ? (bx % 8) * (G / 8) + bx / 8 : bx;
    const int NGW = G * NWAVES;
    unsigned char* ws = args.ws;
    const float* x = (const float*)args.in[0]; const float* cvec = (const float*)args.in[1]; const int* pos = (const int*)args.in[2]; const float* rel_bias = (const float*)args.in[3];
    const float* ada_w = (const float*)args.in[4]; const float* ada_b = (const float*)args.in[5]; const float* ln_mix_g = (const float*)args.in[6]; const float* w_in = (const float*)args.in[7];
    const float* b_gate = (const float*)args.in[8]; const float* g_q = (const float*)args.in[9]; const float* g_kv = (const float*)args.in[10]; const float* w_uq = (const float*)args.in[11];
    const float* w_ukv = (const float*)args.in[12]; const float* sinks = (const float*)args.in[13]; const float* w_o_mla = (const float*)args.in[14]; const float* w_o_swa = (const float*)args.in[15];
    const float* w_o = (const float*)args.in[16]; const float* ln_mlp_g = (const float*)args.in[17]; const float* w_ff1 = (const float*)args.in[18]; const float* w_ff2 = (const float*)args.in[19];
    const float* ln_final_g = (const float*)args.in[20];
    float* out = args.out;
    unsigned* ctl = (unsigned*)(ws + WS_CTL);
    float* ssq_q = (float*)(ws + CTL_SSQ_Q); float* ssq_kv = (float*)(ws + CTL_SSQ_KV); float* ssq1 = (float*)(ws + CTL_SSQ1); float* ssq2 = (float*)(ws + CTL_SSQ2);
    bf16_t* Win_t = (bf16_t*)(ws + WS_WIN); bf16_t* Wuq_t = (bf16_t*)(ws + WS_WUQ); bf16_t* Wukv_t = (bf16_t*)(ws + WS_WUKV); bf16_t* Womla_t = (bf16_t*)(ws + WS_WOMLA);
    bf16_t* Woswa_t = (bf16_t*)(ws + WS_WOSWA); bf16_t* Wo_t = (bf16_t*)(ws + WS_WO); bf16_t* W1_t = (bf16_t*)(ws + WS_W1); bf16_t* W2_t = (bf16_t*)(ws + WS_W2);
    float* mod = (float*)(ws + WS_MOD); float* bias2 = (float*)(ws + WS_BIAS2); float* tbg = (float*)(ws + WS_TB);
    bf16_t* QN = (bf16_t*)(ws + WS_QN); bf16_t* QP = (bf16_t*)(ws + WS_QP); bf16_t* KN = (bf16_t*)(ws + WS_KN); bf16_t* VM = (bf16_t*)(ws + WS_VM);
    float* cs = (float*)(ws + WS_CS); float* sn = (float*)(ws + WS_SN); bf16_t* A2 = (bf16_t*)(ws + WS_A2); bf16_t* X1B = (bf16_t*)(ws + WS_X1B);
    bf16_t* QS = (bf16_t*)(ws + WS_QS); bf16_t* GA = (bf16_t*)(ws + WS_GA); bf16_t* GB = (bf16_t*)(ws + WS_GB); bf16_t* QLAT = (bf16_t*)(ws + WS_QLAT); bf16_t* KVLAT = (bf16_t*)(ws + WS_KVLAT);
    bf16_t* KPE = (bf16_t*)(ws + WS_KPE); bf16_t* KS = (bf16_t*)(ws + WS_KS); bf16_t* VS = (bf16_t*)(ws + WS_VS); bf16_t* U = (bf16_t*)(ws + WS_U);
    bf16_t* YMLA = QN; bf16_t* YSWA = QS;
    bf16_t* H = (bf16_t*)(ws + WS_H); bf16_t* MERGED = (bf16_t*)(ws + WS_MERGED);

    { PHASE_IDS; for (int i = tid; i < (LDS_BYTES - LDSCTL_OFF) / 4; i += NWAVES * 64) ((LAS unsigned*)(lds + LDSCTL_OFF))[i] = 0u; }
    __syncthreads();
    { PHASE_IDS; unsigned* flag = ctl + CW_FLAG;
      if (bx == 0) { if (tid < 278) __hip_atomic_store(ctl + CW_BAR + 64 * tid, 0u, __ATOMIC_RELAXED, __HIP_MEMORY_SCOPE_AGENT);
          asm volatile("s_waitcnt vmcnt(0)" ::: "memory"); __syncthreads();
          if (tid == 0) __hip_atomic_store(flag, CTL_READY, __ATOMIC_RELAXED, __HIP_MEMORY_SCOPE_AGENT); }
      if (tid == 0) { unsigned sp = 0; while (xb_ld(flag) != CTL_READY && ++sp < (1u << 22)) __builtin_amdgcn_s_sleep(1); }
      __syncthreads(); }
    XcdBarrier bar = xcd_barrier_post(ctl + CW_BAR, MISC + 8);
    __syncthreads();
    const int spec_cx = (bar.x < 8u && MISC[8 + 2] < 32u && gridDim.x == 256u) ? (int)(MISC[8 + 2] * 8u + bar.x) : -1;
    f32x4 pfx[8][4];
    { PHASE_IDS; (void)gw; const int rb_ = spec_cx >= 0 ? (spec_cx & 7) * 2048 + ((spec_cx >> 3) & 7) * 256 + (spec_cx >> 6) * 64 + wave * 8 : 0;
#pragma unroll
      for (int q = 0; q < 8; ++q) { const f32x4* xr = (const f32x4*)(x + (size_t)(rb_ + q) * 1024) + lane;
#pragma unroll
          for (int j = 0; j < 4; ++j) pfx[q][j] = __builtin_nontemporal_load(xr + 64 * j); } }

    for (int strip = vcu; strip < 192; strip += G) {
        PHASE_IDS;
        LAS float* sl = (LAS float*)lds; LAS float* part = (LAS float*)(lds + 16384);
        for (int i = tid; i < 4096; i += 512) { const float v = cvec[i]; sl[i] = v / (1.f + __expf(-v)); }
        __syncthreads();
        const int n0 = strip * 32, c4 = lane & 7, kr = lane >> 3;
        const float* Wp = ada_w + (size_t)(128 * wave + kr) * 6144 + n0 + 4 * c4;
        f32x4 wv[16];
#pragma unroll
        for (int i = 0; i < 16; ++i) wv[i] = __builtin_nontemporal_load((const f32x4*)(Wp + (size_t)8 * i * 6144));
        f32x4 a0 = {0.f, 0.f, 0.f, 0.f}, a1 = a0, a2 = a0, a3 = a0;
#pragma unroll
        for (int i = 0; i < 16; ++i) { const int k = 128 * wave + 8 * i + kr; a0 += wv[i] * sl[k]; a1 += wv[i] * sl[1024 + k]; a2 += wv[i] * sl[2048 + k]; a3 += wv[i] * sl[3072 + k]; }
#pragma unroll
        for (int o = 8; o < 64; o <<= 1)
#pragma unroll
            for (int j = 0; j < 4; ++j) { a0[j] += __shfl_xor(a0[j], o); a1[j] += __shfl_xor(a1[j], o); a2[j] += __shfl_xor(a2[j], o); a3[j] += __shfl_xor(a3[j], o); }
        if (lane < 8) { *(LAS f32x4*)(part + (wave * 4 + 0) * 32 + 4 * c4) = a0; *(LAS f32x4*)(part + (wave * 4 + 1) * 32 + 4 * c4) = a1; *(LAS f32x4*)(part + (wave * 4 + 2) * 32 + 4 * c4) = a2; *(LAS f32x4*)(part + (wave * 4 + 3) * 32 + 4 * c4) = a3; }
        __syncthreads();
        if (tid < 128) { const int b = tid >> 5, c = tid & 31; float s = 0.f;
#pragma unroll
            for (int w = 0; w < 8; ++w) s += part[(w * 4 + b) * 32 + c];
            mod[b * 6144 + n0 + c] = s + ada_b[n0 + c]; }
        __syncthreads();
    }
    {
        PHASE_IDS;
        LAS float* scr = (LAS float*)(lds + wave * 16384);
        constexpr int I_WIN = 16 * 117, I_WUQ = 4 * 24, I_WUKV = 2 * 32;
        constexpr int NITEMS = I_WIN + I_WUQ + I_WUKV;
        constexpr int I_WOMLA = 8 * 32, I_WOSWA = 16 * 32, I_WO = 16 * 32, NWO = I_WOMLA + I_WOSWA + I_WO;
#define P0_FIRST_LOAD(it_, wv_) { int r = (it_); if (r < I_WIN) transpose_load(w_in, 3744, r, lane, wv_); else if (r < I_WIN + I_WUQ) transpose_load(w_uq, 768, r - I_WIN, lane, wv_); else transpose_load(w_ukv, 1024, r - I_WIN - I_WUQ, lane, wv_); }
#define P0_FIRST_FIN(it_, wv_) { int r = (it_); if (r < I_WIN) transpose_finish<1>(wv_, 1024, 3744, Win_t, nullptr, scr, r, lane); else if (r < I_WIN + I_WUQ) transpose_finish<2>(wv_, 256, 768, Wuq_t, g_q, scr, r - I_WIN, lane); \
            else transpose_finish<3>(wv_, 128, 1024, Wukv_t, g_kv, scr, r - I_WIN - I_WUQ, lane); }
#define P0_WO_SRC(r_) ((r_) < I_WOMLA ? w_o_mla : (r_) < I_WOMLA + I_WOSWA ? w_o_swa : w_o)
#define P0_WO_LOAD(it_, wv_) { const int r = (it_); transpose_load(P0_WO_SRC(r), 1024, r < I_WOMLA ? r : r < I_WOMLA + I_WOSWA ? r - I_WOMLA : r - I_WOMLA - I_WOSWA, lane, wv_); }
#define P0_WO_FIN(it_, wv_) { const int r = (it_); if (r < I_WOMLA) transpose_finish<0>(wv_, 512, 1024, Womla_t, nullptr, scr, r, lane); else if (r < I_WOMLA + I_WOSWA) transpose_finish<0>(wv_, 1024, 1024, Woswa_t, nullptr, scr, r - I_WOMLA, lane); \
            else transpose_finish<0>(wv_, 1024, 1024, Wo_t, nullptr, scr, r - I_WOMLA - I_WOSWA, lane); }
        if (G == 256 && vcu >= 192) {
            const int i0 = gw, j0 = (vcu - 192) * NWAVES + wave, j1 = j0 + 512, j2 = j0 + 1024;
            float wa[32], wb[32];
            if (i0 < NITEMS) P0_FIRST_LOAD(i0, wa)
            P0_WO_LOAD(j0, wb)
            if (i0 < NITEMS) P0_FIRST_FIN(i0, wa)
            P0_WO_LOAD(j1, wa)
            P0_WO_FIN(j0, wb)
            if (j2 < NWO) P0_WO_LOAD(j2, wb)
            P0_WO_FIN(j1, wa)
            if (j2 < NWO) P0_WO_FIN(j2, wb)
        } else {
        for (int it = gw; it < NITEMS; it += NGW) { float wa[32]; P0_FIRST_LOAD(it, wa) P0_FIRST_FIN(it, wa) }
        { const int nfree = G > 192 ? G - 192 : G, fi = G > 192 ? vcu - 192 : vcu;
          if (fi >= 0) { for (int it = fi * NWAVES + wave; it < NWO; it += nfree * NWAVES) { float wa[32]; P0_WO_LOAD(it, wa) P0_WO_FIN(it, wa) } } }
        }
#undef P0_FIRST_LOAD
#undef P0_FIRST_FIN
#undef P0_WO_SRC
#undef P0_WO_LOAD
#undef P0_WO_FIN
        const int gt = vcu * 512 + tid, NGT = G * 512;
        for (int i = gt; i < 96 * 1024 / 8; i += NGT) *(u32x4*)(Win_t + (size_t)416 * 1024 + (size_t)i * 8) = (u32x4){0u, 0u, 0u, 0u};
        for (int i = gt; i < M * 16; i += NGT) { const int mrow = i >> 4, fi = i & 15; const float ang = (float)pos[mrow] * ROPE_INV[fi];
            double t = (double)ang * 0.15915494309189535; t -= floor(t); const float f = (float)t; cs[i] = __builtin_amdgcn_cosf(f); sn[i] = __builtin_amdgcn_sinf(f); }
        for (int i = gt; i < 16 * 132; i += NGT) { const int hh = i / 132, rel = i - hh * 132; int bkt = rel;
            if (rel >= 16) { const float v = __logf((float)rel * (1.f / 16.f)) * (16.f / 2.0794415416798357f); bkt = 16 + (int)v; if (bkt > 31) bkt = 31; }
            tbg[i] = rel_bias[hh * 32 + bkt] * LOG2E; }
    }
    xcd_barrier(bar);
    if (bx == 0 && threadIdx.x == 0) __hip_atomic_store(ctl + CW_FLAG, 0u, __ATOMIC_RELAXED, __HIP_MEMORY_SCOPE_AGENT);
    chain_setup(bar);
#define chain_local (__builtin_amdgcn_readfirstlane((int)MISC[8 + 3]) != 0)
#define cx __builtin_amdgcn_readfirstlane((int)MISC[8 + 4])

#define P1A_ROW(V, mrow) do { const float* mb = mod + (size_t)((mrow) >> 12) * 6144; float s_ = 0.f; \
        _Pragma("unroll") for (int j = 0; j < 4; ++j) s_ += (V[j][0] * V[j][0] + V[j][1] * V[j][1]) + (V[j][2] * V[j][2] + V[j][3] * V[j][3]); \
        const float rstd_ = __builtin_amdgcn_rsqf(wave_sum(s_) * (1.f / 1024.f) + EPS); \
        _Pragma("unroll") for (int j = 0; j < 4; ++j) { const int c = 4 * lane + 256 * j; const f32x4 g = *(const f32x4*)(ln_mix_g + c), sh = *(const f32x4*)(mb + c), sc = *(const f32x4*)(mb + 1024 + c); \
            *(u32x2*)(H + (size_t)(mrow) * 1024 + c) = pack4(V[j] * rstd_ * g * (sc + 1.f) + sh); } } while (0)
    { PHASE_IDS;
    const bool loc = chain_local;
    if (loc && cx == spec_cx) {
        const int rbase = (cx & 7) * 2048 + ((cx >> 3) & 7) * 256 + (cx >> 6) * 64 + wave * 8;
        const float* mb = mod + (size_t)(rbase >> 12) * 6144; f32x4 gs[4], sh4[4];
#pragma unroll
        for (int j = 0; j < 4; ++j) { const int c = 4 * lane + 256 * j; gs[j] = *(const f32x4*)(ln_mix_g + c) * (*(const f32x4*)(mb + 1024 + c) + 1.f); sh4[j] = *(const f32x4*)(mb + c); }
#pragma unroll
        for (int q = 0; q < 8; ++q) { float s_ = 0.f;
#pragma unroll
            for (int j = 0; j < 4; ++j) s_ += (pfx[q][j][0] * pfx[q][j][0] + pfx[q][j][1] * pfx[q][j][1]) + (pfx[q][j][2] * pfx[q][j][2] + pfx[q][j][3] * pfx[q][j][3]);
            const float rstd_ = __builtin_amdgcn_rsqf(wave_sum(s_) * (1.f / 1024.f) + EPS);
#pragma unroll
            for (int j = 0; j < 4; ++j) *(u32x2*)(H + (size_t)(rbase + q) * 1024 + 4 * lane + 256 * j) = pack4(pfx[q][j] * rstd_ * gs[j] + sh4[j]); }
    } else {
    const int rbase = loc ? (cx & 7) * 2048 + ((cx >> 3) & 7) * 256 + (cx >> 6) * 64 + wave * 8 : gw, rstep = loc ? 1 : NGW, ngrp = loc ? 2 : (M + 4 * NGW - 1) / (4 * NGW);
    for (int gi = 0; gi < ngrp; ++gi) { const int mrow0 = rbase + gi * 4 * rstep;
        f32x4 v[4][4];
#pragma unroll
        for (int q = 0; q < 4; ++q) { const int mrow = mrow0 + q * rstep; if (mrow < M) { const f32x4* xr = (const f32x4*)(x + (size_t)mrow * 1024) + lane;
#pragma unroll
            for (int j = 0; j < 4; ++j) v[q][j] = __builtin_nontemporal_load(xr + 64 * j); } }
#pragma unroll
        for (int q = 0; q < 4; ++q) { const int mrow = mrow0 + q * rstep; if (mrow < M) P1A_ROW(v[q], mrow); }
    }
    }
    }
    if (chain_local) team_barrier(bar); else xcd_barrier(bar);

    {
        pg8::Gemm g{H, Win_t, M, NIN, 1024, nullptr, nullptr, 0}; const int cP1 = cx; pg8::StaticOrder S; S.init(M, NIN, G, cP1);
        EpiP1 E{QLAT, KVLAT, KPE, QS, KS, VS, GA, GB, ssq_q, ssq_kv, cs, sn, b_gate};
        pg8::gemm_phase<EpiP1, true>(lds, g, S, E);
        PHASE_IDS;
        const int nwg = (M / 256) * (NIN / 256), rem = nwg % G, nlight = rem ? G - rem : G, li = rem ? cP1 - rem : cP1;
        if (li >= 0) {
            LAS float* scr = (LAS float*)(lds + wave * 16384);
            constexpr int I_W1 = 16 * 128, I_W2 = 64 * 32, NIT = I_W1 + I_W2;
            for (int it = li * NWAVES + wave; it < NIT; it += nlight * NWAVES) {
                if (it < I_W1) transpose_item<0>(w_ff1, 1024, 4096, W1_t, nullptr, scr, it, lane);
                else transpose_item<0, true>(w_ff2, 4096, 1024, W2_t, nullptr, scr, it - I_W1, lane);
            }
        }
    }
    if (chain_local) team_barrier(bar); else xcd_barrier(bar);

    {
        pg8::Gemm g{QLAT, Wuq_t, M, 768, 256, nullptr, nullptr, 0}; pg8::StaticOrder S; S.init(M, 768, G, cx);
        EpiQ E{QN, QP, ssq_q, cs, sn};
        pg8::gemm_phase<EpiQ, true>(lds, g, S, E);
    }
    { PHASE_IDS; const int nb2 = G > 192 ? G - 192 : G, bi = G > 192 ? cx - 192 : cx;
      if (bi >= 0) {
        LAS float* part = (LAS float*)lds;
        float shv[4][2];
#pragma unroll
        for (int b = 0; b < 4; ++b) { shv[b][0] = mod[(size_t)b * 6144 + 3 * 1024 + 128 * wave + lane]; shv[b][1] = mod[(size_t)b * 6144 + 3 * 1024 + 128 * wave + 64 + lane]; }
        for (int cb = bi; cb < 64; cb += nb2) {
            const float* wp = w_ff1 + (size_t)(128 * wave) * 4096 + cb * 64 + lane;
            float a0 = 0.f, a1 = 0.f, a2 = 0.f, a3 = 0.f;
#pragma unroll
            for (int kk = 0; kk < 128; kk += 32) {
                float wv[32];
#pragma unroll
                for (int i = 0; i < 32; ++i) wv[i] = __builtin_nontemporal_load(wp + (size_t)(kk + i) * 4096);
#pragma unroll
                for (int i = 0; i < 32; ++i) { const int hf = (kk + i) >> 6, l = (kk + i) & 63;
                    a0 += wv[i] * __builtin_bit_cast(float, __builtin_amdgcn_readlane(__builtin_bit_cast(int, shv[0][hf]), l)); a1 += wv[i] * __builtin_bit_cast(float, __builtin_amdgcn_readlane(__builtin_bit_cast(int, shv[1][hf]), l));
                    a2 += wv[i] * __builtin_bit_cast(float, __builtin_amdgcn_readlane(__builtin_bit_cast(int, shv[2][hf]), l)); a3 += wv[i] * __builtin_bit_cast(float, __builtin_amdgcn_readlane(__builtin_bit_cast(int, shv[3][hf]), l)); }
            }
            part[(wave * 4 + 0) * 64 + lane] = a0; part[(wave * 4 + 1) * 64 + lane] = a1; part[(wave * 4 + 2) * 64 + lane] = a2; part[(wave * 4 + 3) * 64 + lane] = a3;
            __syncthreads();
            if (tid < 256) { float sum = 0.f;
#pragma unroll
                for (int w = 0; w < 8; ++w) sum += part[(w * 4 + (tid >> 6)) * 64 + (tid & 63)];
                bias2[(size_t)(tid >> 6) * 4096 + cb * 64 + (tid & 63)] = sum; }
            __syncthreads();
        }
      }
    }
    {
        pg8::Gemm g{KVLAT, Wukv_t, M, 1024, 128, nullptr, nullptr, 0}; pg8::StaticOrder S; S.init(M, 1024, G, cx);
        EpiKV E{KN, VM, ssq_kv};
        pg8::gemm_phase<EpiKV, true>(lds, g, S, E);
    }
    xcd_barrier(bar);

    {
        { PHASE_IDS; LAS float* tb = (LAS float*)(lds + att::SWA_TB_OFF); for (int i = tid; i < 16 * 132; i += 512) tb[i] = tbg[i];
          LAS float* tbx = (LAS float*)(lds + att::SWA_TBX_OFF); for (int i = tid; i < 16 * 384; i += 512) { const int hh = i / 384, d = i - hh * 384 - 128; tbx[i] = (d >= 0 && d < 128) ? tbg[hh * 132 + d] : -INFINITY; } }
        __syncthreads();
        for (int mu = cx; mu < 256; mu += G) {
            const int b = (mu & 7) >> 1, j = mu & 1, r = mu >> 3, p = r & 7, u8 = 4 * (p & 1) + (r >> 3), s = 4 * j + (p >> 1);
            att::mla_unit2(b, u8, 15 - s, QN, QP, KN, KPE, VM, YMLA, lds);
            att::mla_unit2(b, u8, s, QN, QP, KN, KPE, VM, YMLA, lds);
        }
        for (int su = cx; su < 256; su += G) {
            const int b = (su & 7) >> 1, j = su & 1, r = su >> 3, p = r & 7, u8 = 4 * (p & 1) + (r >> 3), qb = pg8::pair_qb(8 * j + (p & 6) + (u8 >> 2));
            att::swa_unit(b, 2 * qb + ((u8 >> 1) & 1), u8 & 1, QS, KS, VS, YSWA, pos, sinks, lds); }
    }
    if (chain_local) pair_barrier(bar); else xcd_barrier(bar);

    {
        pg8::Gemm g{YMLA, Womla_t, M, 1024, 512, YSWA, Woswa_t, 1024}; pg8::StaticOrder S; S.init(M, 1024, G, cx, true);
        EpiMerge E{GA, GB, MERGED};
        pg8::gemm_phase<EpiMerge, true, pg8::NoTail, true>(lds, g, S, E);
    }
    if (chain_local) team_barrier(bar); else xcd_barrier(bar);

    {
        pg8::Gemm g{MERGED, Wo_t, M, 1024, 1024, nullptr, nullptr, 0}; pg8::StaticOrder S; S.init(M, 1024, G, cx, true);
        EpiX1 E{x, X1B, A2, ssq1, mod, ln_mlp_g};
        pg8::gemm_phase<EpiX1, true>(lds, g, S, E);
    }
    if (chain_local) team_barrier(bar); else xcd_barrier(bar);

    {
        pg8::Gemm g{A2, W1_t, M, DFF, 1024, nullptr, nullptr, 0}; pg8::StaticOrder S; S.init(M, DFF, G, cx, true);
        EpiFF1 E{U, ssq1, bias2};
        pg8::gemm_phase<EpiFF1, true>(lds, g, S, E);
    }
    if (chain_local) team_barrier(bar); else xcd_barrier(bar);

    const bool fuse_final = (M / 256) * (DM / 256) <= G;
    {
        pg8::Gemm g{U, W2_t, M, 1024, DFF, nullptr, nullptr, 0}; pg8::StaticOrder S; S.init(M, 1024, G, cx, true);
        EpiX2 E{X1B, out, ssq2, mod, fuse_final}; TailFinal T{out, ssq2, ln_final_g, bar, fuse_final, chain_local};
        pg8::gemm_phase<EpiX2, true, TailFinal, false, 3>(lds, g, S, E, T);
    }
    if (!fuse_final) {
        xcd_barrier(bar);
        PHASE_IDS;
        for (int mrow = gw; mrow < M; mrow += NGW) {
            const f32x4 p4 = *(const f32x4*)(ssq2 + (size_t)mrow * 4); const float rstd = __builtin_amdgcn_rsqf(((p4[0] + p4[1]) + (p4[2] + p4[3])) * (1.f / 1024.f) + EPS);
            f32x4* xr = (f32x4*)(out + (size_t)mrow * 1024) + lane;
#pragma unroll
            for (int j = 0; j < 4; ++j) { const f32x4 g = *(const f32x4*)(ln_final_g + 4 * lane + 256 * j); xr[64 * j] = xr[64 * j] * rstd * g; }
        }
    }
}

extern "C" void kernel_launch(void* const* d_in, const int* in_sizes, int n_in, void* d_out, int out_size, void* d_ws, size_t ws_size, hipStream_t stream) {
    static int grid = 0;
    if (grid == 0) {
        if (n_in != 21 || in_sizes[0] != M * DM || out_size != M * DM || ws_size < WS_END) { fprintf(stderr, "kernel_launch: unexpected shapes (n_in %d, in0 %d, out %d, ws %zu); nothing launched\n", n_in, n_in > 0 ? in_sizes[0] : -1, out_size, ws_size); grid = -1; return; }
        int dev = 0, cus = 0, per_cu = 0;
        if (hipGetDevice(&dev) != hipSuccess || hipDeviceGetAttribute(&cus, hipDeviceAttributeMultiprocessorCount, dev) != hipSuccess) { grid = -1; return; }
        if (hipFuncSetAttribute((const void*)fwd_mega, hipFuncAttributeMaxDynamicSharedMemorySize, LDS_BYTES) != hipSuccess) { fprintf(stderr, "kernel_launch: hipFuncSetAttribute failed\n"); grid = -1; return; }
        if (hipOccupancyMaxActiveBlocksPerMultiprocessor(&per_cu, (const void*)fwd_mega, NWAVES * 64, LDS_BYTES) != hipSuccess || per_cu < 1) { fprintf(stderr, "kernel_launch: occupancy query says %d blocks per CU\n", per_cu); per_cu = 1; }
        (void)hipGetLastError();
        grid = cus;
        if (grid > 256) grid = 256;
    }
    if (grid < 0) return;
    Args a{};
    for (int i = 0; i < 21; ++i) a.in[i] = d_in[i];
    a.out = (float*)d_out; a.ws = (unsigned char*)d_ws;
    void* kargs[] = {&a};
    hipError_t e = hipLaunchCooperativeKernel((const void*)fwd_mega, dim3(grid), dim3(NWAVES * 64), kargs, LDS_BYTES, stream);
    if (e != hipSuccess) fprintf(stderr, "kernel_launch: cooperative launch failed: %s (grid %d)\n", hipGetErrorString(e), grid);
}
```
